# Optimizing an MI355X kernel written in HIP

```python
import math
import jax, jax.numpy as jnp
from jax import lax
import numpy as np

D_MODEL = 1024
BATCH = 16
SEQ = 256
DEPTH = 2
DEC_BATCH = 4
DEC_SEQ = 4096
PAST_LEN = 512

GRID_W = 64
N_MIXERS = 4
W_GROUP = D_MODEL // N_MIXERS
N_COL_GROUPS = 12
A_HEADS = 4
A_DQK = W_GROUP // (2 * A_HEADS)
A_DV = 2 * A_DQK
Q_BLOCK = 128
ROPE_THETA = 10000.0
HY_ORDER = 2
HY_SHORT = 3
HY_BANDS = 8
HY_EMB = 2 * HY_BANDS + 1
HY_HIDDEN = 64
HY_TARGET = 1e-2
HY_DECAY_PCT_SHORT = 0.3
HY_DECAY_PCT_LONG = 1.5
C_HEADS = 4
C_DH = W_GROUP // C_HEADS
C_CHUNK = 64
S5_GROUP = 16
S5_NGROUPS = W_GROUP // S5_GROUP
S5_STATE = 64
S5_DT_MIN = 1e-3
S5_DT_MAX = 1e-1
D_FF = -(-8 * D_MODEL // (3 * 256)) * 256
N_MOD = 6
ALPHA = (2 * DEPTH) ** 0.25
BETA = (8 * DEPTH) ** -0.25
LN_EPS = 1e-5

kernel_name = "hybrid_diff_hyena_hgrn2_s5_prefix_dit"


def _layer_norm(x, gain=None, bias=None):
    xf = x.astype(jnp.float32)
    mu = xf.mean(-1, keepdims=True)
    var = jnp.square(xf - mu).mean(-1, keepdims=True)
    y = (xf - mu) * lax.rsqrt(var + LN_EPS)
    if gain is not None:
        y = y * gain.astype(jnp.float32) + bias.astype(jnp.float32)
    return y.astype(x.dtype)


def _rms_norm(x, gain):
    xf = x.astype(jnp.float32)
    return xf * lax.rsqrt(jnp.mean(xf * xf, -1, keepdims=True) + LN_EPS) * gain.astype(jnp.float32)


def _modulation(cvec, w_mod, b_mod):
    m = jax.nn.silu(cvec) @ w_mod + b_mod
    m = m.reshape(cvec.shape[0], N_MOD, D_MODEL)
    return [m[:, None, i] for i in range(N_MOD)]


def _axial_rope(L):
    rows = L // GRID_W
    r, col = jnp.meshgrid(jnp.arange(rows), jnp.arange(GRID_W), indexing="ij")
    r = r.reshape(-1).astype(jnp.float32)
    col = col.reshape(-1).astype(jnp.float32)
    half = A_DQK // 2
    inv = ROPE_THETA ** (-jnp.arange(0, half, 2, dtype=jnp.float32) / half)
    ang = jnp.stack([r[:, None] * inv, col[:, None] * inv], axis=1)
    return jnp.cos(ang), jnp.sin(ang)


def _apply_rope(x, cos, sin):
    shp = x.shape
    xs = x.astype(jnp.float32).reshape(shp[:-1] + (2, 2, A_DQK // 4))
    x1, x2 = xs[..., 0, :], xs[..., 1, :]
    cs, sn = cos[:, None, None], sin[:, None, None]
    out = jnp.stack([x1 * cs - x2 * sn, x2 * cs + x1 * sn], axis=-2)
    return out.reshape(shp).astype(x.dtype)


def _diff_softmax_blocks(q, keys, vals, lam):
    bsz, lq = q.shape[:2]
    nb = lq // Q_BLOCK
    scale = A_DQK ** -0.5
    qb = q.reshape(bsz, nb, Q_BLOCK, A_HEADS, 2, A_DQK).swapaxes(0, 1)

    def one_block(q_blk):
        s = jnp.einsum("bqhmd,bkhmd->bhmqk", q_blk, keys, preferred_element_type=jnp.float32) * scale
        p = jax.nn.softmax(s, axis=-1)
        w = (p[:, :, 0] - lam * p[:, :, 1]).astype(vals.dtype)
        return jnp.einsum("bhqk,bkhd->bqhd", w, vals)

    o = lax.map(one_block, qb)
    return o.swapaxes(0, 1).reshape(bsz, lq, A_HEADS, A_DV)


def _mixer_diff_attn(aq, ak, av, lam_params, subln_g, layer, rope, ctx_kv):
    bsz, L = aq.shape[:2]
    q = aq.reshape(bsz, L, A_HEADS, 2, A_DQK)
    k = ak.reshape(bsz, L, A_HEADS, 2, A_DQK)
    v = av.reshape(bsz, L, A_HEADS, A_DV)
    lam_init = 0.8 - 0.6 * math.exp(-0.3 * layer)
    lp = lam_params.astype(jnp.float32)
    lam = jnp.exp(jnp.sum(lp[0] * lp[1])) - jnp.exp(jnp.sum(lp[2] * lp[3])) + lam_init
    if ctx_kv is None:
        keys, vals = k, v
    else:
        cos, sin = rope
        ck, cv = ctx_kv
        q = _apply_rope(q, cos, sin)
        ck = ck.reshape(bsz, ck.shape[1], A_HEADS, 2, A_DQK).astype(k.dtype)
        keys = jnp.concatenate([_apply_rope(k, cos, sin), ck], axis=1)
        vals = jnp.concatenate([v, cv.astype(v.dtype)], axis=1)
    o = _diff_softmax_blocks(q, keys, vals, lam)
    o = _rms_norm(o, subln_g) * (1.0 - lam_init)
    return o.reshape(bsz, L, W_GROUP), (k.reshape(bsz, L, A_HEADS, 2 * A_DQK), v)


def _hyena_filters(L, w1, b1, w2, b2, w3, freq):
    t_idx = jnp.arange(L, dtype=jnp.float32)
    t = t_idx / max(L - 1, 1)
    bands = jnp.linspace(1e-4, HY_BANDS - 1, HY_BANDS, dtype=jnp.float32)
    ang = (2.0 * math.pi / L) * t_idx[:, None] * bands[None, :]
    z = jnp.concatenate([t[:, None], jnp.cos(ang), -jnp.sin(ang)], axis=-1)
    fr = freq.astype(jnp.float32)
    h = jnp.sin(fr * (z @ w1.astype(jnp.float32) + b1.astype(jnp.float32)))
    h = jnp.sin(fr * (h @ w2.astype(jnp.float32) + b2.astype(jnp.float32)))
    h = (h @ w3.astype(jnp.float32)).reshape(L, HY_ORDER, 2, W_GROUP)
    slow = math.log(HY_TARGET) / HY_DECAY_PCT_LONG
    quick = math.log(HY_TARGET) / HY_DECAY_PCT_SHORT
    deltas = jnp.abs(jnp.linspace(slow, quick, W_GROUP, dtype=jnp.float32))
    h = h * jnp.exp(-t[:, None] * deltas[None, :])[:, None, None, :]
    fwd = h[:, :, 0]
    bwd = h[1:, :, 1][::-1]
    filt = jnp.concatenate([fwd, jnp.zeros((1, HY_ORDER, W_GROUP), jnp.float32), bwd], axis=0)
    return filt / jnp.sum(jnp.abs(filt), axis=0, keepdims=True)


def _fft_long_conv(u, filt, bias):
    L = u.shape[1]
    uf = jnp.fft.rfft(u.astype(jnp.float32), n=2 * L, axis=1)
    ff = jnp.fft.rfft(filt, n=2 * L, axis=0)
    y = jnp.fft.irfft(uf * ff[None], n=2 * L, axis=1)[:, :L]
    return y + u.astype(jnp.float32) * bias.astype(jnp.float32)


def _mixer_hyena(hv, hx1, hx2, short_w, short_b, w1, b1, w2, b2, w3, freq, bias):
    u = jnp.concatenate([hv, hx1, hx2], axis=-1)
    L = u.shape[1]
    pad = HY_SHORT // 2
    up = jnp.pad(u, ((0, 0), (pad, pad), (0, 0)))
    u = sum(up[:, j:j + L] * short_w[j] for j in range(HY_SHORT)) + short_b
    v, x1, x2 = jnp.split(u.astype(jnp.float32), 3, axis=-1)
    filt = _hyena_filters(L, w1, b1, w2, b2, w3, freq)
    y = x1 * _fft_long_conv(v, filt[:, 0], bias[0])
    y = x2 * _fft_long_conv(y, filt[:, 1], bias[1])
    return y


def _hgrn_scan(q, k, v, logf, s0):
    bsz, L = q.shape[:2]
    nc = L // C_CHUNK

    def to_chunks(a):
        return a.astype(jnp.float32).reshape(bsz, nc, C_CHUNK, C_HEADS, C_DH).transpose(1, 0, 3, 2, 4)

    mask = jnp.tril(jnp.ones((C_CHUNK, C_CHUNK), bool))[:, :, None]

    def step(S, inp):
        qc, kc, vc, gc = inp
        b = jnp.cumsum(gc, axis=2)
        inter = jnp.einsum("bhtd,bhde->bhte", qc * jnp.exp(b), S)
        rel = b[:, :, :, None, :] - b[:, :, None, :, :]
        decay = jnp.exp(jnp.where(mask, rel, -jnp.inf))
        att = jnp.einsum("bhtd,bhsd,bhtsd->bhts", qc, kc, decay)
        o = inter + jnp.einsum("bhts,bhse->bhte", att, vc)
        b_last = b[:, :, -1:]
        S = jnp.exp(b_last[:, :, 0])[..., None] * S + jnp.einsum("bhsd,bhse->bhde", kc * jnp.exp(b_last - b), vc)
        return S, o

    S, o = lax.scan(step, s0.astype(jnp.float32), (to_chunks(q), to_chunks(k), to_chunks(v), to_chunks(logf)))
    return o.transpose(1, 0, 3, 2, 4).reshape(bsz, L, C_HEADS, C_DH), S


def _mixer_hgrn(cq, ci, cff, cfb, cg, lb, norm_g, s0):
    bsz, L = cq.shape[:2]
    shp = (bsz, L, C_HEADS, C_DH)
    q = jax.nn.silu(cq.astype(jnp.float32)).reshape(shp)
    v = ci.astype(jnp.float32).reshape(shp)
    if s0 is None:
        s0 = jnp.zeros((bsz, 2, C_HEADS, C_DH, C_DH), jnp.float32)
    o = 0.0
    finals = []
    for d, zf in enumerate((cff, cfb)):
        f = lb[d] + (1.0 - lb[d]) * jax.nn.sigmoid(zf.astype(jnp.float32))
        args = (q, (1.0 - f).reshape(shp), v, jnp.log(f).reshape(shp))
        if d == 1:
            args = tuple(jnp.flip(a, axis=1) for a in args)
        od, sd = _hgrn_scan(*args, s0[:, d])
        o = o + (od if d == 0 else jnp.flip(od, axis=1))
        finals.append(sd)
    o = _rms_norm(o, norm_g) * jax.nn.silu(cg.astype(jnp.float32)).reshape(shp)
    return o.reshape(bsz, L, W_GROUP), jnp.stack(finals, axis=1)


def _ssm_combine(e1, e2):
    a1, b1 = e1
    a2, b2 = e2
    return a1 * a2, a2 * b1 + b2


def _s5_scan(u, lam_re, lam_im, bmat, cmat, log_dt, s0):
    lam = lax.complex(lam_re.astype(jnp.float32), lam_im.astype(jnp.float32))
    dt = jnp.exp(log_dt.astype(jnp.float32))[:, None]
    a_bar = jnp.exp(lam * dt)
    bc = lax.complex(bmat[..., 0].astype(jnp.float32), bmat[..., 1].astype(jnp.float32))
    cc = lax.complex(cmat[..., 0].astype(jnp.float32), cmat[..., 1].astype(jnp.float32))
    b_bar = ((a_bar - 1.0) / lam)[..., None] * bc
    bu = jnp.einsum("gph,blgh->blgp", b_bar, u.astype(jnp.complex64))
    a = jnp.broadcast_to(a_bar, bu.shape)
    a_cum, xs = lax.associative_scan(_ssm_combine, (a, bu), axis=1)
    xs = xs + a_cum * s0[:, None]
    y = jnp.einsum("ghp,blgp->blgh", cc, xs).real
    return y, xs[:, -1]


def _mixer_s5(su, lam_re, lam_im, bmat, cmat, log_dt, d_skip, glu_w, glu_b, s0):
    bsz, L = su.shape[:2]
    u = su.astype(jnp.float32).reshape(bsz, L, S5_NGROUPS, S5_GROUP)
    if s0 is None:
        s0c = jnp.zeros((bsz, 2, S5_NGROUPS, S5_STATE), jnp.complex64)
    else:
        s0f = s0.astype(jnp.float32)
        s0c = lax.complex(s0f[..., 0], s0f[..., 1])
    y = u * d_skip.astype(jnp.float32).reshape(S5_NGROUPS, S5_GROUP)
    finals = []
    for d in range(2):
        ud = u if d == 0 else jnp.flip(u, axis=1)
        yd, sd = _s5_scan(ud, lam_re[d], lam_im[d], bmat[d], cmat[d], log_dt[d], s0c[:, d])
        y = y + (yd if d == 0 else jnp.flip(yd, axis=1))
        finals.append(sd)
    z = jax.nn.gelu(y.reshape(bsz, L, W_GROUP))
    out = z * jax.nn.sigmoid(z @ glu_w.astype(jnp.float32) + glu_b.astype(jnp.float32))
    st = jnp.stack(finals, axis=1)
    return out, jnp.stack([st.real, st.imag], axis=-1)


def _block(x, cvec, layer, p, lb, rope=None, ctx=None):
    sh1, sc1, g1, sh2, sc2, g2 = _modulation(cvec, p["w_mod"], p["b_mod"])
    h = _layer_norm(x) * (1 + sc1) + sh1
    (aq, ak, av, hv, hx1, hx2, cq, ci, cff, cfb, cg, su) = jnp.split(h @ p["w_in"], N_COL_GROUPS, axis=-1)
    oa, kv = _mixer_diff_attn(aq, ak, av, p["diff_lambda"], p["diff_subln_g"], layer, rope,
                              None if ctx is None else (ctx[0], ctx[1]))
    ob = _mixer_hyena(hv, hx1, hx2, p["hy_short_w"], p["hy_short_b"], p["hy_pos_w1"], p["hy_pos_b1"],
                      p["hy_pos_w2"], p["hy_pos_b2"], p["hy_pos_w3"], p["hy_freq"], p["hy_bias"])
    oc, hgrn_state = _mixer_hgrn(cq, ci, cff, cfb, cg, lb, p["hgrn_norm_g"], None if ctx is None else ctx[2])
    od, s5_state = _mixer_s5(su, p["s5_lambda_re"], p["s5_lambda_im"], p["s5_b"], p["s5_c"], p["s5_log_dt"],
                             p["s5_d"], p["s5_glu_w"], p["s5_glu_b"], None if ctx is None else ctx[3])
    mixed = jnp.concatenate([o.astype(x.dtype) for o in (oa, ob, oc, od)], axis=-1) @ p["w_out"]
    x = _layer_norm(ALPHA * x + g1 * mixed, p["ln_g"][0], p["ln_b"][0])
    h = _layer_norm(x) * (1 + sc2) + sh2
    gate, up = jnp.split(h @ p["w_ffn_in"], 2, axis=-1)
    ffn = (jax.nn.silu(gate) * up) @ p["w_ffn_out"]
    x = _layer_norm(ALPHA * x + g2 * ffn, p["ln_g"][1], p["ln_b"][1])
    return x, (kv[0], kv[1], hgrn_state, s5_state)


def setup_inputs(seed: int = 0) -> dict:
    key = jax.random.key(seed)
    ks = iter(jax.random.split(key, 48))

    def nrm(shape, scale):
        return jax.random.normal(next(ks), shape, jnp.float32) * scale

    n_idx = jnp.arange(S5_STATE, dtype=jnp.float32)
    return {
        "x_prompt": nrm((BATCH, SEQ, D_MODEL), 1.0),
        "x_sample": nrm((DEC_BATCH, DEC_SEQ, D_MODEL), 1.0),
        "c": nrm((DEC_BATCH, D_MODEL), 1.0),
        "cache_attn_k": nrm((DEC_BATCH, DEPTH, PAST_LEN, A_HEADS, 2 * A_DQK), 1.0),
        "cache_attn_v": nrm((DEC_BATCH, DEPTH, PAST_LEN, A_HEADS, A_DV), 1.0),
        "state_hgrn": nrm((DEC_BATCH, DEPTH, 2, C_HEADS, C_DH, C_DH), 0.5),
        "state_s5": nrm((DEC_BATCH, DEPTH, 2, S5_NGROUPS, S5_STATE, 2), 0.5),
        "c_ctx": nrm((D_MODEL,), 1.0),
        "w_mod": nrm((DEPTH, D_MODEL, N_MOD * D_MODEL), 0.5 * D_MODEL ** -0.5),
        "b_mod": nrm((DEPTH, N_MOD * D_MODEL), 0.02),
        "ln_g": 1.0 + nrm((DEPTH, 2, D_MODEL), 0.02),
        "ln_b": nrm((DEPTH, 2, D_MODEL), 0.02),
        "w_in": nrm((DEPTH, D_MODEL, N_COL_GROUPS * W_GROUP), D_MODEL ** -0.5),
        "w_out": nrm((DEPTH, N_MIXERS * W_GROUP, D_MODEL), BETA * (N_MIXERS * W_GROUP) ** -0.5),
        "diff_lambda": nrm((DEPTH, 4, A_DQK), 0.1),
        "diff_subln_g": 1.0 + nrm((DEPTH, A_DV), 0.02),
        "hy_short_w": nrm((DEPTH, HY_SHORT, 3 * W_GROUP), HY_SHORT ** -0.5),
        "hy_short_b": nrm((DEPTH, 3 * W_GROUP), 0.02),
        "hy_pos_w1": nrm((DEPTH, HY_EMB, HY_HIDDEN), HY_EMB ** -0.5),
        "hy_pos_b1": nrm((DEPTH, HY_HIDDEN), 0.1),
        "hy_pos_w2": nrm((DEPTH, HY_HIDDEN, HY_HIDDEN), HY_HIDDEN ** -0.5),
        "hy_pos_b2": nrm((DEPTH, HY_HIDDEN), 0.1),
        "hy_pos_w3": nrm((DEPTH, HY_HIDDEN, HY_ORDER * 2 * W_GROUP), HY_HIDDEN ** -0.5),
        "hy_freq": 1.0 + nrm((DEPTH, HY_HIDDEN), 0.02),
        "hy_bias": nrm((DEPTH, HY_ORDER, W_GROUP), 0.1),
        "hgrn_lb": nrm((DEPTH, 2, W_GROUP), 0.1),
        "hgrn_norm_g": 1.0 + nrm((DEPTH, C_DH), 0.02),
        "s5_lambda_re": -0.5 + nrm((DEPTH, 2, S5_NGROUPS, S5_STATE), 0.01),
        "s5_lambda_im": math.pi * n_idx + nrm((DEPTH, 2, S5_NGROUPS, S5_STATE), 0.01),
        "s5_b": nrm((DEPTH, 2, S5_NGROUPS, S5_STATE, S5_GROUP, 2), (2 * S5_GROUP) ** -0.5),
        "s5_c": nrm((DEPTH, 2, S5_NGROUPS, S5_GROUP, S5_STATE, 2), S5_STATE ** -0.5),
        "s5_log_dt": jax.random.uniform(next(ks), (DEPTH, 2, S5_NGROUPS), jnp.float32,
                                        math.log(S5_DT_MIN), math.log(S5_DT_MAX)),
        "s5_d": nrm((DEPTH, W_GROUP), 1.0),
        "s5_glu_w": nrm((DEPTH, W_GROUP, W_GROUP), W_GROUP ** -0.5),
        "s5_glu_b": nrm((DEPTH, W_GROUP), 0.02),
        "w_ffn_in": nrm((DEPTH, D_MODEL, 2 * D_FF), D_MODEL ** -0.5),
        "w_ffn_out": nrm((DEPTH, D_FF, D_MODEL), BETA * D_FF ** -0.5),
    }


def reference(x_prompt, x_sample, c, cache_attn_k, cache_attn_v, state_hgrn, state_s5,
              c_ctx, w_mod, b_mod, ln_g, ln_b, w_in, w_out, diff_lambda, diff_subln_g,
              hy_short_w, hy_short_b, hy_pos_w1, hy_pos_b1, hy_pos_w2, hy_pos_b2, hy_pos_w3,
              hy_freq, hy_bias, hgrn_lb, hgrn_norm_g, s5_lambda_re, s5_lambda_im, s5_b, s5_c,
              s5_log_dt, s5_d, s5_glu_w, s5_glu_b, w_ffn_in, w_ffn_out):
    stacked = {
        "w_mod": w_mod, "b_mod": b_mod, "ln_g": ln_g, "ln_b": ln_b, "w_in": w_in, "w_out": w_out,
        "diff_lambda": diff_lambda, "diff_subln_g": diff_subln_g,
        "hy_short_w": hy_short_w, "hy_short_b": hy_short_b, "hy_pos_w1": hy_pos_w1, "hy_pos_b1": hy_pos_b1,
        "hy_pos_w2": hy_pos_w2, "hy_pos_b2": hy_pos_b2, "hy_pos_w3": hy_pos_w3, "hy_freq": hy_freq,
        "hy_bias": hy_bias, "hgrn_norm_g": hgrn_norm_g,
        "s5_lambda_re": s5_lambda_re, "s5_lambda_im": s5_lambda_im, "s5_b": s5_b, "s5_c": s5_c,
        "s5_log_dt": s5_log_dt, "s5_d": s5_d, "s5_glu_w": s5_glu_w, "s5_glu_b": s5_glu_b,
        "w_ffn_in": w_ffn_in, "w_ffn_out": w_ffn_out,
    }
    lb_cum = jnp.cumsum(jax.nn.softmax(hgrn_lb.astype(jnp.float32), axis=0), axis=0)
    lower_bounds = lb_cum - lb_cum[0]
    rope = _axial_rope(x_sample.shape[1])
    c_ctx_row = c_ctx[None]
    y_prompt, y_sample = x_prompt, x_sample
    ks, vs, hs, ss = [], [], [], []
    for layer in range(DEPTH):
        p = {name: arr[layer] for name, arr in stacked.items()}
        y_prompt, (k_l, v_l, h_l, s_l) = _block(y_prompt, c_ctx_row, layer, p, lower_bounds[layer])
        ks.append(k_l)
        vs.append(v_l)
        hs.append(h_l)
        ss.append(s_l)
        ctx = (cache_attn_k[:, layer], cache_attn_v[:, layer], state_hgrn[:, layer], state_s5[:, layer])
        y_sample, _ = _block(y_sample, c, layer, p, lower_bounds[layer], rope, ctx)
    new_attn_k = jnp.stack(ks, axis=1)
    new_attn_v = jnp.stack(vs, axis=1)
    new_hgrn_state = jnp.stack(hs, axis=1)
    new_s5_state = jnp.stack(ss, axis=1)
    return (y_prompt, y_sample, new_attn_k, new_attn_v, new_hgrn_state, new_s5_state)
```

```cpp
#include <hip/hip_runtime.h>
#include <hip/hip_cooperative_groups.h>
#include <stdint.h>
#include <stdio.h>
namespace cg = cooperative_groups;

#ifndef MULTI
#define MULTI 0
#endif

#ifndef PQ_ATT
#define PQ_ATT 1
#endif
#ifndef PQ_CONV
#define PQ_CONV 1
#endif
#ifndef PQ_HY
#define PQ_HY 1
#endif
#ifndef PQ_H1
#define PQ_H1 1
#endif
#define DI __device__ __forceinline__
typedef unsigned short u16;
typedef __attribute__((ext_vector_type(8))) short bf16x8;
typedef __attribute__((ext_vector_type(4))) float f32x4;
typedef __attribute__((ext_vector_type(16))) float f32x16;
typedef __bf16 bf2_t __attribute__((ext_vector_type(2)));
typedef float f2_t __attribute__((ext_vector_type(2)));
#define MFMA32(a, b, c) __builtin_amdgcn_mfma_f32_32x32x16_bf16((a), (b), (c), 0, 0, 0)
#define MFMA16(a, b, c) __builtin_amdgcn_mfma_f32_16x16x32_bf16((a), (b), (c), 0, 0, 0)

constexpr int TP = 4096, TS = 16384, TT = 20480;
constexpr int NCH32 = 640;
constexpr float LN_EPS = 1e-5f;
constexpr float ALPHA = 1.41421356237f;
constexpr float QSCALE = 0.17677669529f * 1.44269504089f;

constexpr size_t SZ_WT_IN = 3072ull * 1024 * 2, SZ_WT_OUT = 1024ull * 1024 * 2, SZ_WT_FFI = 5632ull * 1024 * 2,
                 SZ_WT_FFO = 1024ull * 2816 * 2, SZ_WT_GLU = 256ull * 256 * 2;
constexpr size_t O_WT_IN = 0;
constexpr size_t O_WT_OUT = O_WT_IN + SZ_WT_IN;
constexpr size_t O_WT_FFI = O_WT_OUT + SZ_WT_OUT;
constexpr size_t O_WT_FFO = O_WT_FFI + SZ_WT_FFI;
constexpr size_t O_WT_GLU = O_WT_FFO + SZ_WT_FFO;
constexpr size_t O_MOD = O_WT_GLU + SZ_WT_GLU;
constexpr size_t O_ROPE = O_MOD + 2ull * 5 * 6144 * 4;
constexpr size_t O_LBV = O_ROPE + 4096ull * 16 * 8;
constexpr size_t O_AT = O_LBV + 4096;
constexpr size_t O_BAR = O_AT + 16384;
constexpr size_t O_HYF = O_BAR + 65536;
constexpr size_t SZ_HYF_S = 4ull * 256 * 4096 * 2, SZ_HYF_P = 4ull * 256 * 256 * 2;
constexpr size_t O_ACAT = O_HYF + SZ_HYF_S + SZ_HYF_P;
constexpr size_t O_EMAT = O_ACAT + 16ull * 512 * 768 * 2;
constexpr size_t O_HMIX = O_EMAT + 16ull * 256 * 512 * 2;
constexpr size_t O_BIG = O_HMIX + (size_t)TT * 1024 * 2;
constexpr size_t O_QKV = O_BIG;
constexpr size_t O_HYT = O_QKV + (size_t)TT * 768 * 2;
constexpr size_t O_HG = O_HYT + (size_t)TT * 768 * 2;
constexpr size_t O_ACT = O_BIG;
constexpr size_t O_ZS5 = O_BIG;
constexpr size_t O_BCAT = O_BIG + (size_t)TT * 2816 * 2;
constexpr size_t O_XLOC = O_BCAT + 16ull * NCH32 * 768 * 2;
constexpr size_t O_HGO = O_XLOC + 16ull * NCH32 * 256 * 4;
constexpr size_t O_SLOC = O_HGO + 2ull * TT * 256 * 2;
constexpr size_t O_SDEC = O_SLOC + 32ull * 16 * 4096 * 4;
constexpr size_t O_KTAB = O_SDEC + 32ull * 16 * 64 * 4;
constexpr size_t WS_TOTAL = O_KTAB + 16ull * 2 * 32 * 256 * 4;

constexpr size_t OUT_K = (size_t)TT * 1024;
constexpr size_t OUT_V = OUT_K + 16ull * 2 * 256 * 256;
constexpr size_t OUT_HG = OUT_V + 16ull * 2 * 256 * 256;
constexpr size_t OUT_S5 = OUT_HG + 16ull * 2 * 2 * 4 * 4096;

struct Params {
  const float *x_prompt, *x_sample, *c, *cache_k, *cache_v, *state_hgrn, *state_s5, *c_ctx, *w_mod, *b_mod, *ln_g, *ln_b,
      *w_in, *w_out, *diff_lambda, *diff_subln_g, *hy_short_w, *hy_short_b, *hy_w1, *hy_b1, *hy_w2, *hy_b2, *hy_w3, *hy_freq,
      *hy_bias, *hgrn_lb, *hgrn_norm_g, *s5_lre, *s5_lim, *s5_b, *s5_c, *s5_logdt, *s5_d, *s5_glu_w, *s5_glu_b, *w_ffi, *w_ffo;
  float* out;
  char* ws;
};

DI int tidx() {
  int t = threadIdx.x;
  asm volatile("" : "+v"(t));
  return t;
}
template <class T>
DI T* lnd(T* x) {
  asm volatile("" : "+s"(x));
  return x;
}
DI float bf2f(u16 h) { return __uint_as_float(((unsigned)h) << 16); }
DI unsigned pack2(float a, float b) {
  f2_t v = {a, b};
  bf2_t r = __builtin_convertvector(v, bf2_t);
  return __builtin_bit_cast(unsigned, r);
}
DI u16 f2bf(float x) { return (u16)(pack2(x, 0.f) & 0xffffu); }
DI int crow(int i, int h) { return (i & 3) + 8 * (i >> 2) + 4 * h; }
#define DPPF_(val, ctrl, rm) __builtin_bit_cast(float, __builtin_amdgcn_update_dpp(0, __builtin_bit_cast(int, (val)), (ctrl), (rm), 0xF, false))
DI float wave_sum(float v) {
  v += DPPF_(v, 0xB1, 0xF);
  v += DPPF_(v, 0x4E, 0xF);
  v += DPPF_(v, 0x141, 0xF);
  v += DPPF_(v, 0x140, 0xF);
  v += DPPF_(v, 0x142, 0xA);
  v += DPPF_(v, 0x143, 0xC);
  return __builtin_bit_cast(float, __builtin_amdgcn_readlane(__builtin_bit_cast(int, v), 63));
}
DI float frcp_(float x) { return __builtin_amdgcn_rcpf(x); }
DI float sigmoidf_(float x) { return frcp_(1.f + __expf(-x)); }
DI float siluf_(float x) { return x * frcp_(1.f + __expf(-x)); }
DI float gelu_tanh(float x) {
  float u = 0.7978845608f * (x + 0.044715f * x * x * x);
  float t = 1.f - 2.f * frcp_(1.f + __expf(2.f * u));
  return 0.5f * x * (1.f + t);
}
DI int modvec(int row) { return row < TP ? 0 : 1 + ((row - TP) >> 12); }

struct NoHook {
  DI void operator()() const {}
};
template <class Epi, class Hook = NoHook>
DI void gemm_tile(const u16* __restrict__ A, int lda, int M, const u16* __restrict__ B, int ldb, int N, int K, int tm,
                  int tn, Epi& epi, char* smem, Hook hook = Hook()) {
  u16* As = (u16*)smem;
  u16* Bs = As + 128 * 72;
  const int tid = tidx(), lane = tid & 63, w = tid >> 6, wm = w >> 1, wn = w & 1;
  const int lr = tid >> 3, lc = (tid & 7) * 8;
  f32x16 acc[2][2];
#pragma unroll
  for (int a = 0; a < 2; ++a)
#pragma unroll
    for (int b = 0; b < 2; ++b)
#pragma unroll
      for (int i = 0; i < 16; ++i) acc[a][b][i] = 0.f;
  uint4 ra0, ra1, ra2, ra3, rb0, rb1, rb2, rb3;
  uint4 sa0, sa1, sa2, sa3, sb0, sb1, sb2, sb3;
  const u16* Ab = A + lc;
  const u16* Bb = B + lc;
  const int ar0 = tm * 128 + lr, br0 = tn * 128 + lr;
#define GL_A(q) (*(const uint4*)(Ab + (size_t)min(ar0 + 32 * (q), M - 1) * lda + kk))
#define GL_B(q) (*(const uint4*)(Bb + (size_t)min(br0 + 32 * (q), N - 1) * ldb + kk))
#define LOAD_R(KK) { const int kk = (KK); ra0 = GL_A(0); ra1 = GL_A(1); ra2 = GL_A(2); ra3 = GL_A(3); rb0 = GL_B(0); rb1 = GL_B(1); rb2 = GL_B(2); rb3 = GL_B(3); }
#define LOAD_S(KK) { const int kk = (KK); sa0 = GL_A(0); sa1 = GL_A(1); sa2 = GL_A(2); sa3 = GL_A(3); sb0 = GL_B(0); sb1 = GL_B(1); sb2 = GL_B(2); sb3 = GL_B(3); }
#define STORE_T(a0, a1, a2, a3, b0, b1, b2, b3)          \
  *(uint4*)(As + (lr + 0) * 72 + lc) = a0;               \
  *(uint4*)(As + (lr + 32) * 72 + lc) = a1;              \
  *(uint4*)(As + (lr + 64) * 72 + lc) = a2;              \
  *(uint4*)(As + (lr + 96) * 72 + lc) = a3;              \
  *(uint4*)(Bs + (lr + 0) * 72 + lc) = b0;               \
  *(uint4*)(Bs + (lr + 32) * 72 + lc) = b1;              \
  *(uint4*)(Bs + (lr + 64) * 72 + lc) = b2;              \
  *(uint4*)(Bs + (lr + 96) * 72 + lc) = b3;
#define COMPUTE_T()                                                                                                  \
  __builtin_amdgcn_s_setprio(1);                                                                                     \
  _Pragma("unroll") for (int ks = 0; ks < 4; ++ks) {                                                                 \
    bf16x8 af[2], bf[2];                                                                                             \
    _Pragma("unroll") for (int mi = 0; mi < 2; ++mi)                                                                 \
      af[mi] = *(const bf16x8*)(As + (wm * 64 + mi * 32 + (lane & 31)) * 72 + ks * 16 + (lane >> 5) * 8);            \
    _Pragma("unroll") for (int ni = 0; ni < 2; ++ni)                                                                 \
      bf[ni] = *(const bf16x8*)(Bs + (wn * 64 + ni * 32 + (lane & 31)) * 72 + ks * 16 + (lane >> 5) * 8);            \
    _Pragma("unroll") for (int mi = 0; mi < 2; ++mi)                                                                 \
      _Pragma("unroll") for (int ni = 0; ni < 2; ++ni) acc[mi][ni] = MFMA32(af[mi], bf[ni], acc[mi][ni]);            \
  }                                                                                                                  \
  __builtin_amdgcn_s_setprio(0);
  LOAD_R(0);
  LOAD_S(64);
  for (int k0 = 0; k0 < K; k0 += 128) {
    __syncthreads();
    STORE_T(ra0, ra1, ra2, ra3, rb0, rb1, rb2, rb3);
    __syncthreads();
    if (k0 + 128 < K) LOAD_R(k0 + 128);
    COMPUTE_T();
    __syncthreads();
    STORE_T(sa0, sa1, sa2, sa3, sb0, sb1, sb2, sb3);
    __syncthreads();
    if (k0 + 192 < K) LOAD_S(k0 + 192);
    COMPUTE_T();
  }
#undef GL_A
#undef GL_B
#undef LOAD_R
#undef LOAD_S
#undef STORE_T
#undef COMPUTE_T
  hook();
  epi(tm * 128 + wm * 64, tn * 128 + wn * 64, acc);
}

template <class Epi, class Hook = NoHook>
DI void gemm_tile_w(const u16* __restrict__ A, int lda, int M, const u16* __restrict__ B, int ldb, int N, int K, int tm,
                    int tn, Epi& epi, char* smem, Hook hook = Hook()) {
  u16* As = (u16*)smem;
  u16* Bs = As + 128 * 72;
  const int tid = tidx(), lane = tid & 63, w = tid >> 6, wm = w >> 1, wn = w & 1;
  const int lr = tid >> 3, lc = (tid & 7) * 8;
  f32x16 acc[2][2][2];
#pragma unroll
  for (int hh = 0; hh < 2; ++hh)
#pragma unroll
    for (int a = 0; a < 2; ++a)
#pragma unroll
      for (int b = 0; b < 2; ++b)
#pragma unroll
        for (int i = 0; i < 16; ++i) acc[hh][a][b][i] = 0.f;
  uint4 ra0, ra1, ra2, ra3, rb0, rb1, rb2, rb3, rb4, rb5, rb6, rb7;
  const u16* Ab = A + lc;
  const u16* Bb = B + lc;
  const int ar0 = tm * 128 + lr, br0 = tn * 256 + lr;
#define GL_A(q) (*(const uint4*)(Ab + (size_t)min(ar0 + 32 * (q), M - 1) * lda + kk))
#define GL_B(q) (*(const uint4*)(Bb + (size_t)min(br0 + 32 * (q), N - 1) * ldb + kk))
  {
    const int kk = 0;
    ra0 = GL_A(0); ra1 = GL_A(1); ra2 = GL_A(2); ra3 = GL_A(3);
    rb0 = GL_B(0); rb1 = GL_B(1); rb2 = GL_B(2); rb3 = GL_B(3);
    rb4 = GL_B(4); rb5 = GL_B(5); rb6 = GL_B(6); rb7 = GL_B(7);
  }
  for (int k0 = 0; k0 < K; k0 += 64) {
    __syncthreads();
    *(uint4*)(As + (lr + 0) * 72 + lc) = ra0;
    *(uint4*)(As + (lr + 32) * 72 + lc) = ra1;
    *(uint4*)(As + (lr + 64) * 72 + lc) = ra2;
    *(uint4*)(As + (lr + 96) * 72 + lc) = ra3;
    *(uint4*)(Bs + (lr + 0) * 72 + lc) = rb0;
    *(uint4*)(Bs + (lr + 32) * 72 + lc) = rb1;
    *(uint4*)(Bs + (lr + 64) * 72 + lc) = rb2;
    *(uint4*)(Bs + (lr + 96) * 72 + lc) = rb3;
    *(uint4*)(Bs + (lr + 128) * 72 + lc) = rb4;
    *(uint4*)(Bs + (lr + 160) * 72 + lc) = rb5;
    *(uint4*)(Bs + (lr + 192) * 72 + lc) = rb6;
    *(uint4*)(Bs + (lr + 224) * 72 + lc) = rb7;
    __syncthreads();
    if (k0 + 64 < K) {
      const int kk = k0 + 64;
      ra0 = GL_A(0); ra1 = GL_A(1); ra2 = GL_A(2); ra3 = GL_A(3);
      rb0 = GL_B(0); rb1 = GL_B(1); rb2 = GL_B(2); rb3 = GL_B(3);
      rb4 = GL_B(4); rb5 = GL_B(5); rb6 = GL_B(6); rb7 = GL_B(7);
    }
    __builtin_amdgcn_s_setprio(1);
#pragma unroll
    for (int ks = 0; ks < 4; ++ks) {
      bf16x8 af[2], bf[4];
#pragma unroll
      for (int mi = 0; mi < 2; ++mi)
        af[mi] = *(const bf16x8*)(As + (wm * 64 + mi * 32 + (lane & 31)) * 72 + ks * 16 + (lane >> 5) * 8);
#pragma unroll
      for (int nj = 0; nj < 4; ++nj)
        bf[nj] = *(const bf16x8*)(Bs + (wn * 128 + nj * 32 + (lane & 31)) * 72 + ks * 16 + (lane >> 5) * 8);
#pragma unroll
      for (int mi = 0; mi < 2; ++mi)
#pragma unroll
        for (int nj = 0; nj < 4; ++nj) acc[nj >> 1][mi][nj & 1] = MFMA32(af[mi], bf[nj], acc[nj >> 1][mi][nj & 1]);
    }
    __builtin_amdgcn_s_setprio(0);
  }
#undef GL_A
#undef GL_B
  hook();
  epi(tm * 128 + wm * 64, tn * 256 + wn * 128, acc[0]);
  epi(tm * 128 + wm * 64, tn * 256 + wn * 128 + 64, acc[1]);
}

struct EpiWin {
  const Params& p;
  int l;
  DI void operator()(int row0, int col0, f32x16 (&acc)[2][2]) const {
    const int lane = tidx() & 63, h = lane >> 5, c32 = lane & 31;
    u16* qkv = (u16*)(p.ws + O_QKV);
    u16* hyT = (u16*)(p.ws + O_HYT);
    u16* hg = (u16*)(p.ws + O_HG);
    u16* bcat = (u16*)(p.ws + O_BCAT);
    const float2* rope = (const float2*)(p.ws + O_ROPE);
#pragma unroll
    for (int mi = 0; mi < 2; ++mi) {
      const int rb = row0 + mi * 32;
#pragma unroll
      for (int ni = 0; ni < 2; ++ni) {
        const int cb = col0 + ni * 32, col = cb + c32;
        if (cb < 768) {
          const bool sample = rb >= TP;
#pragma unroll
          for (int i = 0; i < 16; ++i) {
            const int row = rb + crow(i, h);
            float v = acc[mi][ni][i];
            if (cb < 512) {
              if (sample) {
                const int pos = (row - TP) & 4095, idx = col & 31;
                const float2 cs = rope[pos * 16 + (idx >> 4) * 8 + (idx & 7)];
                const float pv = __shfl_xor(v, 8);
                v = ((idx >> 3) & 1) ? (v * cs.x + pv * cs.y) : (v * cs.x - pv * cs.y);
              } else if (cb >= 256) {
                const int b = row >> 8, t = row & 255;
                p.out[OUT_K + ((size_t)((b * 2 + l) * 256 + t)) * 256 + (col - 256)] = v;
              }
              if (cb < 256) v *= QSCALE;
            } else if (!sample) {
              const int b = row >> 8, t = row & 255;
              p.out[OUT_V + ((size_t)((b * 2 + l) * 256 + t)) * 256 + (col - 512)] = v;
            }
            qkv[(size_t)row * 768 + col] = f2bf(v);
          }
        } else if (cb < 1536) {
          const int c = col - 768;
#pragma unroll
          for (int g4 = 0; g4 < 4; ++g4) {
            uint2 pk;
            pk.x = pack2(acc[mi][ni][4 * g4], acc[mi][ni][4 * g4 + 1]);
            pk.y = pack2(acc[mi][ni][4 * g4 + 2], acc[mi][ni][4 * g4 + 3]);
            *(uint2*)(hyT + (size_t)c * TT + rb + 8 * g4 + 4 * h) = pk;
          }
        } else if (cb < 2816) {
#pragma unroll
          for (int i = 0; i < 16; ++i) {
            const int row = rb + crow(i, h);
            hg[(size_t)row * 1280 + (col - 1536)] = f2bf(acc[mi][ni][i]);
          }
        } else {
          const int cu = col - 2816, g = cu >> 4, hh = cu & 15;
#pragma unroll
          for (int i = 0; i < 16; ++i) {
            const int row = rb + crow(i, h);
            bcat[((size_t)(g * NCH32 + (row >> 5))) * 768 + (row & 31) * 16 + hh] = f2bf(acc[mi][ni][i]);
          }
        }
      }
    }
  }
};

struct EpiRes {
  const Params& p;
  const float* xp;
  const float* xs;
  const float* gate;
  DI void operator()(int row0, int col0, f32x16 (&acc)[2][2]) const {
    const int lane = tidx() & 63, h = lane >> 5, c32 = lane & 31;
#pragma unroll
    for (int mi = 0; mi < 2; ++mi)
#pragma unroll
      for (int ni = 0; ni < 2; ++ni) {
        const int col = col0 + ni * 32 + c32;
#pragma unroll
        for (int i = 0; i < 16; ++i) {
          const int row = row0 + mi * 32 + crow(i, h);
          const float g = gate[modvec(row) * 6144 + col];
          const float xin = row < TP ? xp[(size_t)row * 1024 + col] : xs[(size_t)(row - TP) * 1024 + col];
          p.out[(size_t)row * 1024 + col] = ALPHA * xin + g * acc[mi][ni][i];
        }
      }
  }
};

struct EpiFfnIn {
  const Params& p;
  DI void operator()(int row0, int col0, f32x16 (&acc)[2][2]) const {
    const int lane = tidx() & 63, h = lane >> 5, c32 = lane & 31;
    u16* act = (u16*)(p.ws + O_ACT);
    const int j = (col0 >> 6) * 32 + c32;
#pragma unroll
    for (int mi = 0; mi < 2; ++mi)
#pragma unroll
      for (int i = 0; i < 16; ++i) {
        const int row = row0 + mi * 32 + crow(i, h);
        const float g = acc[mi][0][i], u = acc[mi][1][i];
        act[(size_t)row * 2816 + j] = f2bf(siluf_(g) * u);
      }
  }
};

struct EpiS5E {
  const Params& p;
  int g;
  DI void operator()(int row0, int col0, f32x16 (&acc)[2][2]) const {
    const int lane = tidx() & 63, h = lane >> 5, c32 = lane & 31;
    float* xloc = (float*)(p.ws + O_XLOC);
#pragma unroll
    for (int mi = 0; mi < 2; ++mi)
#pragma unroll
      for (int ni = 0; ni < 2; ++ni) {
        const int col = col0 + ni * 32 + c32;
#pragma unroll
        for (int i = 0; i < 16; ++i) {
          const int row = row0 + mi * 32 + crow(i, h);
          if (row < NCH32) xloc[((size_t)(g * NCH32 + row)) * 256 + col] = acc[mi][ni][i];
        }
      }
  }
};

struct EpiS5Y {
  const Params& p;
  int g;
  DI void operator()(int row0, int col0, f32x16 (&acc)[2][2]) const {
    const int lane = tidx() & 63, h = lane >> 5, c32 = lane & 31;
    u16* zs5 = (u16*)(p.ws + O_ZS5);
#pragma unroll
    for (int mi = 0; mi < 2; ++mi)
#pragma unroll
      for (int ni = 0; ni < 2; ++ni) {
        const int chunk = col0 + ni * 32 + c32;
#pragma unroll
        for (int i = 0; i < 16; ++i) {
          const int m = row0 + mi * 32 + crow(i, h);
          if (chunk < NCH32)
            zs5[((size_t)(chunk * 32 + (m >> 4))) * 256 + g * 16 + (m & 15)] = f2bf(gelu_tanh(acc[mi][ni][i]));
        }
      }
  }
};

struct EpiGlu {
  const Params& p;
  int l;
  DI void operator()(int row0, int col0, f32x16 (&acc)[2][2]) const {
    const int lane = tidx() & 63, h = lane >> 5, c32 = lane & 31;
    const u16* zs5 = (const u16*)(p.ws + O_ZS5);
    u16* mix = (u16*)(p.ws + O_HMIX);
#pragma unroll
    for (int mi = 0; mi < 2; ++mi)
#pragma unroll
      for (int ni = 0; ni < 2; ++ni) {
        const int col = col0 + ni * 32 + c32;
        const float bb = lnd(p.s5_glu_b)[l * 256 + col];
#pragma unroll
        for (int i = 0; i < 16; ++i) {
          const int row = row0 + mi * 32 + crow(i, h);
          const float z = bf2f(zs5[(size_t)row * 256 + col]);
          mix[(size_t)row * 1024 + 768 + col] = f2bf(z * sigmoidf_(acc[mi][ni][i] + bb));
        }
      }
  }
};

DI void convert_tile(const float* __restrict__ W, int K, int N, u16* __restrict__ Wt, int perm, int item, char* smem) {
  float(*tile)[65] = (float(*)[65])smem;
  const int tid = tidx();
  const int tilesN = N >> 6, kt = item / tilesN, nt = item % tilesN;
  __syncthreads();
#pragma unroll
  for (int q = 0; q < 4; ++q) {
    const int r = q * 16 + (tid >> 4), cq = (tid & 15) * 4;
    const float4 v = *(const float4*)(W + (size_t)(kt * 64 + r) * N + nt * 64 + cq);
    tile[r][cq] = v.x;
    tile[r][cq + 1] = v.y;
    tile[r][cq + 2] = v.z;
    tile[r][cq + 3] = v.w;
  }
  __syncthreads();
#pragma unroll
  for (int q = 0; q < 2; ++q) {
    const int idx = tid + q * 256, n = idx >> 3, kq = idx & 7;
    uint4 o;
    o.x = pack2(tile[kq * 8 + 0][n], tile[kq * 8 + 1][n]);
    o.y = pack2(tile[kq * 8 + 2][n], tile[kq * 8 + 3][n]);
    o.z = pack2(tile[kq * 8 + 4][n], tile[kq * 8 + 5][n]);
    o.w = pack2(tile[kq * 8 + 6][n], tile[kq * 8 + 7][n]);
    int nn = nt * 64 + n;
    if (perm) nn = nn < 2816 ? ((nn >> 5) * 64 + (nn & 31)) : ((((nn - 2816) >> 5) * 64) + 32 + ((nn - 2816) & 31));
    *(uint4*)(Wt + (size_t)nn * K + kt * 64 + kq * 8) = o;
  }
}

constexpr int CV_IN = 16 * 48, CV_OUT = 16 * 16, CV_FFI = 16 * 88, CV_FFO = 44 * 16, CV_GLU = 16;
constexpr int CV_TOTAL = CV_IN + CV_OUT + CV_FFI + CV_FFO + CV_GLU;
DI void convert_item(const Params& p, int l, int item, char* smem) {
  if (item < CV_IN) return convert_tile(lnd(p.w_in) + (size_t)l * 1024 * 3072, 1024, 3072, (u16*)(p.ws + O_WT_IN), 0, item, smem);
  item -= CV_IN;
  if (item < CV_OUT) return convert_tile(lnd(p.w_out) + (size_t)l * 1024 * 1024, 1024, 1024, (u16*)(p.ws + O_WT_OUT), 0, item, smem);
  item -= CV_OUT;
  if (item < CV_FFI) return convert_tile(lnd(p.w_ffi) + (size_t)l * 1024 * 5632, 1024, 5632, (u16*)(p.ws + O_WT_FFI), 1, item, smem);
  item -= CV_FFI;
  if (item < CV_FFO) return convert_tile(lnd(p.w_ffo) + (size_t)l * 2816 * 1024, 2816, 1024, (u16*)(p.ws + O_WT_FFO), 0, item, smem);
  item -= CV_FFO;
  convert_tile(lnd(p.s5_glu_w) + (size_t)l * 256 * 256, 256, 256, (u16*)(p.ws + O_WT_GLU), 0, item, smem);
}

DI void mod_item(const Params& p, int item, char* smem) {
  float* s = (float*)smem;
  float* red = s + 5 * 1024;
  const int tid = tidx(), lane = tid & 63, w = tid >> 6;
  const int l = item / 96, n = (item % 96) * 64 + lane;
  __syncthreads();
  for (int i = tid; i < 5120; i += 256) {
    const int v = i >> 10, k = i & 1023;
    const float x = v == 0 ? lnd(p.c_ctx)[k] : lnd(p.c)[(v - 1) * 1024 + k];
    s[i] = x / (1.f + expf(-x));
  }
  __syncthreads();
  float a0 = 0, a1 = 0, a2 = 0, a3 = 0, a4 = 0;
  const float* W = lnd(p.w_mod) + ((size_t)l * 1024 + w * 256) * 6144 + n;
#pragma unroll 16
  for (int k = 0; k < 256; ++k) {
    const float wv = W[(size_t)k * 6144];
    const int kk = w * 256 + k;
    a0 += s[kk] * wv;
    a1 += s[1024 + kk] * wv;
    a2 += s[2048 + kk] * wv;
    a3 += s[3072 + kk] * wv;
    a4 += s[4096 + kk] * wv;
  }
  red[(w * 5 + 0) * 64 + lane] = a0;
  red[(w * 5 + 1) * 64 + lane] = a1;
  red[(w * 5 + 2) * 64 + lane] = a2;
  red[(w * 5 + 3) * 64 + lane] = a3;
  red[(w * 5 + 4) * 64 + lane] = a4;
  __syncthreads();
  float* mod = (float*)(p.ws + O_MOD);
  for (int i = tid; i < 320; i += 256) {
    const int v = i >> 6, ln = i & 63, nn = (item % 96) * 64 + ln;
    float t = lnd(p.b_mod)[l * 6144 + nn];
    for (int ww = 0; ww < 4; ++ww) t += red[(ww * 5 + v) * 64 + ln];
    mod[(size_t)(l * 5 + v) * 6144 + nn] = t;
  }
}

DI void rope_item(const Params& p, int item) {
  const int idx = item * 256 + tidx();
  const int pos = idx >> 4, a = (idx >> 3) & 1, f = idx & 7;
  const float coord = a == 0 ? (float)(pos >> 6) : (float)(pos & 63);
  const float inv = powf(10000.f, -(float)(2 * f) / 16.f);
  const float ang = coord * inv;
  float2 cs;
  cs.x = cosf(ang);
  cs.y = sinf(ang);
  ((float2*)(p.ws + O_ROPE))[idx] = cs;
}

DI void lbv_item(const Params& p) {
  float* lbv = (float*)(p.ws + O_LBV);
  for (int i = tidx(); i < 512; i += 256) {
    const float e0 = lnd(p.hgrn_lb)[i], e1 = lnd(p.hgrn_lb)[512 + i];
    const float m = fmaxf(e0, e1);
    const float x0 = expf(e0 - m), x1 = expf(e1 - m);
    lbv[i] = 0.f;
    lbv[512 + i] = x1 / (x0 + x1);
  }
}

DI void hyf_item(const Params& p, int l, int item, char* smem) {
  const int tid = tidx();
  const bool sample = item < 256;
  const int L = sample ? 4096 : 256;
  const int l0 = (sample ? item : item - 256) * 16;
  float* z = (float*)smem;
  float* h1 = z + 16 * 17;
  float* h2 = h1 + 16 * 64;
  __syncthreads();
  for (int i = tid; i < 16 * 17; i += 256) {
    const int li = i / 17, k = i % 17;
    const float tl = (float)(l0 + li);
    float val;
    if (k == 0) val = tl / (float)(L - 1);
    else {
      const int b = (k - 1) & 7;
      const float band = 1e-4f + (float)b * ((7.f - 1e-4f) / 7.f);
      const float ang = (6.283185307179586f / (float)L) * tl * band;
      val = k <= 8 ? cosf(ang) : -sinf(ang);
    }
    z[i] = val;
  }
  __syncthreads();
  const float* w1 = lnd(p.hy_w1) + l * 17 * 64;
  const float* w2 = lnd(p.hy_w2) + l * 64 * 64;
  const float* w3 = lnd(p.hy_w3) + (size_t)l * 64 * 1024;
  for (int i = tid; i < 1024; i += 256) {
    const int li = i >> 6, j = i & 63;
    float a = lnd(p.hy_b1)[l * 64 + j];
#pragma unroll
    for (int k = 0; k < 17; ++k) a += z[li * 17 + k] * w1[k * 64 + j];
    h1[i] = sinf(lnd(p.hy_freq)[l * 64 + j] * a);
  }
  __syncthreads();
  for (int i = tid; i < 1024; i += 256) {
    const int li = i >> 6, j = i & 63;
    float a = lnd(p.hy_b2)[l * 64 + j];
#pragma unroll 16
    for (int k = 0; k < 64; ++k) a += h1[li * 64 + k] * w2[k * 64 + j];
    h2[i] = sinf(lnd(p.hy_freq)[l * 64 + j] * a);
  }
  __syncthreads();
  u16* dst = (u16*)(p.ws + O_HYF + (sample ? 0 : SZ_HYF_S));
  const float slow = logf(1e-2f) / 1.5f, quick = logf(1e-2f) / 0.3f;
#pragma unroll 1
  for (int cc = 0; cc < 4; ++cc) {
    const int col = tid + cc * 256;
    float acc[16];
#pragma unroll
    for (int li = 0; li < 16; ++li) acc[li] = 0.f;
#pragma unroll 8
    for (int k = 0; k < 64; ++k) {
      const float wv = w3[k * 1024 + col];
#pragma unroll
      for (int li = 0; li < 16; ++li) acc[li] += h2[li * 64 + k] * wv;
    }
    const int ch = col & 255;
    const float delta = fabsf(slow + (quick - slow) * ((float)ch / 255.f));
    unsigned pk[8];
#pragma unroll
    for (int li = 0; li < 16; li += 2) {
      const float t0 = (float)(l0 + li) / (float)(L - 1), t1 = (float)(l0 + li + 1) / (float)(L - 1);
      pk[li >> 1] = pack2(acc[li] * expf(-t0 * delta), acc[li + 1] * expf(-t1 * delta));
    }
    u16* d = dst + ((size_t)col) * L + l0;
    *(uint4*)(d) = make_uint4(pk[0], pk[1], pk[2], pk[3]);
    *(uint4*)(d + 8) = make_uint4(pk[4], pk[5], pk[6], pk[7]);
  }
}

DI void s5prep_item(const Params& p, int l, int item, char* smem) {
  const int tid = tidx();
  const int g = item >> 5, t = item & 31;
  float2* apow = (float2*)smem;
  float2* Bb = apow + 33 * 64;
  float2* Cc = Bb + 64 * 16;
  u16* acat = (u16*)(p.ws + O_ACAT) + (size_t)g * 512 * 768;
  u16* emat = (u16*)(p.ws + O_EMAT) + (size_t)g * 256 * 512;
  const int h = tid >> 4, hp = tid & 15;
#pragma unroll 1
  for (int dir = 0; dir < 2; ++dir) {
    const int bld = (l * 2 + dir) * 16 + g;
    const float dt = expf(lnd(p.s5_logdt)[bld]);
    __syncthreads();
    for (int i = tid; i < 33 * 64; i += 256) {
      const int j = i >> 6, pp = i & 63;
      const float re = lnd(p.s5_lre)[bld * 64 + pp], im = lnd(p.s5_lim)[bld * 64 + pp];
      const float mag = expf((float)j * re * dt), ang = (float)j * im * dt;
      apow[i] = make_float2(mag * cosf(ang), mag * sinf(ang));
    }
    for (int i = tid; i < 1024; i += 256) {
      const int pp = i >> 4, hh = i & 15;
      const float re = lnd(p.s5_lre)[bld * 64 + pp], im = lnd(p.s5_lim)[bld * 64 + pp];
      const float mag = expf(re * dt), ang = im * dt;
      const float nr = mag * cosf(ang) - 1.f, ni = mag * sinf(ang);
      const float den = 1.f / (re * re + im * im);
      const float cr = (nr * re + ni * im) * den, ci = (ni * re - nr * im) * den;
      const float br = lnd(p.s5_b)[((size_t)(bld * 64 + pp) * 16 + hh) * 2], bi = lnd(p.s5_b)[((size_t)(bld * 64 + pp) * 16 + hh) * 2 + 1];
      Bb[i] = make_float2(cr * br - ci * bi, cr * bi + ci * br);
    }
    for (int i = tid; i < 1024; i += 256) {
      const int hh = i >> 6, pp = i & 63;
      Cc[i] = make_float2(lnd(p.s5_c)[((size_t)(bld * 16 + hh) * 64 + pp) * 2], lnd(p.s5_c)[((size_t)(bld * 16 + hh) * 64 + pp) * 2 + 1]);
    }
    __syncthreads();
    {
      float kacc = 0.f;
      for (int pp = 0; pp < 64; ++pp) {
        const float2 cv = Cc[h * 64 + pp], bv = Bb[pp * 16 + hp], a = apow[t * 64 + pp];
        const float dr = cv.x * bv.x - cv.y * bv.y, di = cv.x * bv.y + cv.y * bv.x;
        kacc += dr * a.x - di * a.y;
      }
      ((float*)(p.ws + O_KTAB))[((size_t)((g * 2 + dir) * 32 + t)) * 256 + tid] = kacc;
    }
    for (int i = tid; i < 1024; i += 256) {
      const int hh = i >> 6, pp = i & 63;
      const int e = dir == 0 ? t + 1 : 32 - t;
      const float2 cv = Cc[i], a = apow[e * 64 + pp];
      const float wr = cv.x * a.x - cv.y * a.y, wi = cv.x * a.y + cv.y * a.x;
      *(unsigned*)(acat + (size_t)(t * 16 + hh) * 768 + 512 + dir * 128 + pp * 2) = pack2(wr, -wi);
    }
    for (int i = tid; i < 1024; i += 256) {
      const int pp = i >> 4, hh = i & 15;
      const int e = dir == 0 ? 31 - t : t;
      const float2 bv = Bb[i], a = apow[e * 64 + pp];
      const float wr = a.x * bv.x - a.y * bv.y, wi = a.x * bv.y + a.y * bv.x;
      emat[(size_t)(dir * 128 + pp * 2) * 512 + t * 16 + hh] = f2bf(wr);
      emat[(size_t)(dir * 128 + pp * 2 + 1) * 512 + t * 16 + hh] = f2bf(wi);
    }
    if (t == 0 && tid < 64) ((float2*)(p.ws + O_AT))[(dir * 16 + g) * 64 + tid] = apow[32 * 64 + tid];
  }
}

DI void s5expand_item(const Params& p, int l, int item) {
  const int tid = tidx();
  const int g = item >> 5, t = item & 31, h = tid >> 4, hp = tid & 15;
  u16* acat = (u16*)(p.ws + O_ACAT) + (size_t)g * 512 * 768;
  const float* kf = (const float*)(p.ws + O_KTAB) + (size_t)(g * 2 + 0) * 32 * 256 + tid;
  const float* kb = (const float*)(p.ws + O_KTAB) + (size_t)(g * 2 + 1) * 32 * 256 + tid;
  const float dsk = lnd(p.s5_d)[l * 256 + g * 16 + h];
#pragma unroll 8
  for (int r = 0; r < 32; ++r) {
    float v = 0.f;
    if (t >= r) v += kf[(t - r) * 256];
    if (r >= t) v += kb[(r - t) * 256];
    if (r == t && h == hp) v += dsk;
    acat[(size_t)(t * 16 + h) * 768 + r * 16 + hp] = f2bf(v);
  }
}

DI void ln_item(const Params& p, int item, const float* srcP, const float* srcS, const float* G, const float* B,
                const float* modl, int shi, int sci) {
  const int tid = tidx(), lane = tid & 63, w = tid >> 6;
  const int row0 = item * 8 + w * 2;
  const float* src = row0 < TP ? srcP + (size_t)row0 * 1024 : srcS + (size_t)(row0 - TP) * 1024;
  float4 v[2][4];
#pragma unroll
  for (int r = 0; r < 2; ++r)
#pragma unroll
    for (int i = 0; i < 4; ++i) v[r][i] = *(const float4*)(src + r * 1024 + lane * 4 + 256 * i);
  float mean[2], rstd[2];
#pragma unroll
  for (int r = 0; r < 2; ++r) {
    float s = 0.f;
#pragma unroll
    for (int i = 0; i < 4; ++i) s += v[r][i].x + v[r][i].y + v[r][i].z + v[r][i].w;
    mean[r] = wave_sum(s) * (1.f / 1024.f);
    float q = 0.f;
#pragma unroll
    for (int i = 0; i < 4; ++i) {
      v[r][i].x -= mean[r]; v[r][i].y -= mean[r]; v[r][i].z -= mean[r]; v[r][i].w -= mean[r];
      q += v[r][i].x * v[r][i].x + v[r][i].y * v[r][i].y + v[r][i].z * v[r][i].z + v[r][i].w * v[r][i].w;
    }
    rstd[r] = rsqrtf(wave_sum(q) * (1.f / 1024.f) + LN_EPS);
  }
  if (G) {
#pragma unroll
    for (int r = 0; r < 2; ++r) {
      float s2 = 0.f;
#pragma unroll
      for (int i = 0; i < 4; ++i) {
        const int col = lane * 4 + 256 * i;
        const float4 g = *(const float4*)(G + col), b = *(const float4*)(B + col);
        v[r][i].x = v[r][i].x * rstd[r] * g.x + b.x;
        v[r][i].y = v[r][i].y * rstd[r] * g.y + b.y;
        v[r][i].z = v[r][i].z * rstd[r] * g.z + b.z;
        v[r][i].w = v[r][i].w * rstd[r] * g.w + b.w;
        *(float4*)(p.out + (size_t)(row0 + r) * 1024 + col) = v[r][i];
        s2 += v[r][i].x + v[r][i].y + v[r][i].z + v[r][i].w;
      }
      mean[r] = s2;
    }
    if (!modl) return;
#pragma unroll
    for (int r = 0; r < 2; ++r) {
      const float m2 = wave_sum(mean[r]) * (1.f / 1024.f);
      float q = 0.f;
#pragma unroll
      for (int i = 0; i < 4; ++i) {
        v[r][i].x -= m2; v[r][i].y -= m2; v[r][i].z -= m2; v[r][i].w -= m2;
        q += v[r][i].x * v[r][i].x + v[r][i].y * v[r][i].y + v[r][i].z * v[r][i].z + v[r][i].w * v[r][i].w;
      }
      rstd[r] = rsqrtf(wave_sum(q) * (1.f / 1024.f) + LN_EPS);
    }
  }
  const float* mv = modl + modvec(row0) * 6144;
#pragma unroll
  for (int r = 0; r < 2; ++r) {
    u16* hb = (u16*)(p.ws + O_HMIX) + (size_t)(row0 + r) * 1024;
#pragma unroll
    for (int i = 0; i < 4; ++i) {
      const int col = lane * 4 + 256 * i;
      const float4 sc = *(const float4*)(mv + sci * 1024 + col), sh = *(const float4*)(mv + shi * 1024 + col);
      uint2 o;
      o.x = pack2(v[r][i].x * rstd[r] * (1.f + sc.x) + sh.x, v[r][i].y * rstd[r] * (1.f + sc.y) + sh.y);
      o.y = pack2(v[r][i].z * rstd[r] * (1.f + sc.z) + sh.z, v[r][i].w * rstd[r] * (1.f + sc.w) + sh.w);
      *(uint2*)(hb + col) = o;
    }
  }
}

DI void attn_item(const Params& p, int l, int item, char* smem) {
  const int tid = tidx(), lane = tid & 63, w = tid >> 6, h = lane >> 5, c32 = lane & 31;
  int b, head, qb, rowK0, Llat, ncache;
  if (item < 512) {
    b = item >> 7; head = (item >> 5) & 3; qb = item & 31;
    rowK0 = TP + b * 4096; Llat = 4096; ncache = 512;
  } else {
    const int it = item - 512;
    b = it >> 3; head = (it >> 1) & 3; qb = it & 1;
    rowK0 = b * 256; Llat = 256; ncache = 0;
  }
  const int ntiles = (Llat + ncache) >> 6;
  const u16* qkv = (const u16*)(p.ws + O_QKV);
  u16* Ks = (u16*)smem;
  u16* Vt = Ks + 64 * 72;
  float lam, oml;
  {
    const float* lp = lnd(p.diff_lambda) + l * 128;
    const float s1 = wave_sum(c32 == lane ? lp[c32] * lp[32 + c32] : 0.f);
    const float s2 = wave_sum(c32 == lane ? lp[64 + c32] * lp[96 + c32] : 0.f);
    const float lam_init = 0.8f - 0.6f * expf(-0.3f * (float)l);
    lam = expf(s1) - expf(s2) + lam_init;
    oml = 1.f - lam_init;
  }
  const int qrow = rowK0 + qb * 128 + w * 32 + c32;
  bf16x8 qf[2][2];
#pragma unroll
  for (int m = 0; m < 2; ++m)
#pragma unroll
    for (int ks = 0; ks < 2; ++ks)
      qf[m][ks] = *(const bf16x8*)(qkv + (size_t)qrow * 768 + head * 64 + m * 32 + ks * 16 + h * 8);

  uint4 kreg[2], vreg[2];
  const int vkp = c32, veg = w * 2 + h;
  auto load_tile = [&](int tile) {
    if (tile * 64 < Llat) {
#pragma unroll
      for (int q = 0; q < 2; ++q) {
        const int id = tid + 256 * q, key = id >> 3, part = id & 7;
        const size_t row = rowK0 + tile * 64 + key;
        kreg[q] = *(const uint4*)(qkv + row * 768 + 256 + head * 64 + part * 8);
        const size_t vrow = rowK0 + tile * 64 + 2 * vkp + q;
        vreg[q] = *(const uint4*)(qkv + vrow * 768 + 512 + head * 64 + veg * 8);
      }
    } else {
#pragma unroll
      for (int q = 0; q < 2; ++q) {
        const int id = tid + 256 * q, key = id >> 3, part = id & 7;
        const int t = tile * 64 - Llat + key;
        const size_t off = ((size_t)((b * 2 + l) * 512 + t) * 4 + head) * 64 + part * 8;
        const float4 k0 = *(const float4*)(lnd(p.cache_k) + off), k1 = *(const float4*)(lnd(p.cache_k) + off + 4);
        kreg[q] = make_uint4(pack2(k0.x, k0.y), pack2(k0.z, k0.w), pack2(k1.x, k1.y), pack2(k1.z, k1.w));
        const int tv = tile * 64 - Llat + 2 * vkp + q;
        const size_t voff = ((size_t)((b * 2 + l) * 512 + tv) * 4 + head) * 64 + veg * 8;
        const float4 v0 = *(const float4*)(lnd(p.cache_v) + voff), v1 = *(const float4*)(lnd(p.cache_v) + voff + 4);
        vreg[q] = make_uint4(pack2(v0.x, v0.y), pack2(v0.z, v0.w), pack2(v1.x, v1.y), pack2(v1.z, v1.w));
      }
    }
  };
  f32x16 O[2][2];
#pragma unroll
  for (int m = 0; m < 2; ++m)
#pragma unroll
    for (int e = 0; e < 2; ++e)
#pragma unroll
      for (int i = 0; i < 16; ++i) O[m][e][i] = 0.f;
  float mold[2] = {-1e30f, -1e30f}, lsum[2] = {0.f, 0.f};
  load_tile(0);
  for (int tile = 0; tile < ntiles; ++tile) {
    __syncthreads();
#pragma unroll
    for (int q = 0; q < 2; ++q) {
      const int id = tid + 256 * q, key = id >> 3, part = id & 7;
      *(uint4*)(Ks + key * 72 + part * 8) = kreg[q];
    }
    {
      const unsigned va[4] = {vreg[0].x, vreg[0].y, vreg[0].z, vreg[0].w};
      const unsigned vb[4] = {vreg[1].x, vreg[1].y, vreg[1].z, vreg[1].w};
      unsigned* Vd = (unsigned*)Vt;
#pragma unroll
      for (int j = 0; j < 4; ++j) {
        Vd[(veg * 8 + 2 * j) * 36 + vkp] = (va[j] & 0xffffu) | (vb[j] << 16);
        Vd[(veg * 8 + 2 * j + 1) * 36 + vkp] = (va[j] >> 16) | (vb[j] & 0xffff0000u);
      }
    }
    __syncthreads();
    if (tile + 1 < ntiles) load_tile(tile + 1);
#pragma unroll
    for (int m = 0; m < 2; ++m) {
      uint4 pf[2][2];
      {
        f32x16 s[2];
#pragma unroll
        for (int kb = 0; kb < 2; ++kb) {
#pragma unroll
          for (int i = 0; i < 16; ++i) s[kb][i] = 0.f;
#pragma unroll
          for (int ks = 0; ks < 2; ++ks) {
            const bf16x8 a = *(const bf16x8*)(Ks + (kb * 32 + c32) * 72 + m * 32 + ks * 16 + h * 8);
            s[kb] = MFMA32(a, qf[m][ks], s[kb]);
          }
        }
        float mx = s[0][0];
#pragma unroll
        for (int i = 0; i < 16; ++i) mx = fmaxf(mx, fmaxf(s[0][i], s[1][i]));
        mx = fmaxf(mx, __shfl_xor(mx, 32));
        const float mnew = fmaxf(mold[m], mx);
        const float alpha = __builtin_amdgcn_exp2f(mold[m] - mnew);
        mold[m] = mnew;
        float rs = 0.f;
#pragma unroll
        for (int kb = 0; kb < 2; ++kb) {
#pragma unroll
          for (int i = 0; i < 16; ++i) {
            const float pv = __builtin_amdgcn_exp2f(s[kb][i] - mnew);
            s[kb][i] = pv;
            rs += pv;
          }
#pragma unroll
          for (int sp = 0; sp < 2; ++sp)
            pf[kb][sp] = make_uint4(pack2(s[kb][8 * sp], s[kb][8 * sp + 1]), pack2(s[kb][8 * sp + 2], s[kb][8 * sp + 3]),
                                    pack2(s[kb][8 * sp + 4], s[kb][8 * sp + 5]), pack2(s[kb][8 * sp + 6], s[kb][8 * sp + 7]));
        }
        lsum[m] = lsum[m] * alpha + rs;
        if (__builtin_amdgcn_ballot_w64(alpha < 1.f) != 0) {
#pragma unroll
          for (int e = 0; e < 2; ++e)
#pragma unroll
            for (int i = 0; i < 16; ++i) O[m][e][i] *= alpha;
        }
      }
#pragma unroll
      for (int kb = 0; kb < 2; ++kb)
#pragma unroll
        for (int sp = 0; sp < 2; ++sp) {
          const bf16x8 pfr = __builtin_bit_cast(bf16x8, pf[kb][sp]);
#pragma unroll
          for (int e = 0; e < 2; ++e) {
            const u16* vp = Vt + (e * 32 + c32) * 72 + kb * 32 + sp * 16 + 4 * h;
            const uint2 lo = *(const uint2*)vp, hi = *(const uint2*)(vp + 8);
            const uint4 t4 = make_uint4(lo.x, lo.y, hi.x, hi.y);
            O[m][e] = MFMA32(__builtin_bit_cast(bf16x8, t4), pfr, O[m][e]);
          }
        }
    }
  }
  const float l1 = lsum[0] + __shfl_xor(lsum[0], 32), l2 = lsum[1] + __shfl_xor(lsum[1], 32);
  const float inv1 = 1.f / l1, inv2 = lam / l2;
  float ss = 0.f;
#pragma unroll
  for (int e = 0; e < 2; ++e)
#pragma unroll
    for (int i = 0; i < 16; ++i) {
      const float o = O[0][e][i] * inv1 - O[1][e][i] * inv2;
      O[0][e][i] = o;
      ss += o * o;
    }
  ss += __shfl_xor(ss, 32);
  const float r = rsqrtf(ss * (1.f / 64.f) + LN_EPS) * oml;
  u16* mix = (u16*)(p.ws + O_HMIX);
  const float* sg = lnd(p.diff_subln_g) + l * 64;
#pragma unroll
  for (int e = 0; e < 2; ++e)
#pragma unroll
    for (int g4 = 0; g4 < 4; ++g4) {
      const int e0 = e * 32 + 8 * g4 + 4 * h;
      uint2 o;
      o.x = pack2(O[0][e][4 * g4] * r * sg[e0], O[0][e][4 * g4 + 1] * r * sg[e0 + 1]);
      o.y = pack2(O[0][e][4 * g4 + 2] * r * sg[e0 + 2], O[0][e][4 * g4 + 3] * r * sg[e0 + 3]);
      *(uint2*)(mix + (size_t)qrow * 1024 + head * 64 + e0) = o;
    }
}

DI void shortconv4(const u16* seq, int t0, int L, float w0, float w1, float w2, float sb, float (&o)[4]) {
  const uint2 c = *(const uint2*)(seq + t0);
  const float x0 = bf2f((u16)(c.x & 0xffff)), x1 = bf2f((u16)(c.x >> 16)), x2 = bf2f((u16)(c.y & 0xffff)), x3 = bf2f((u16)(c.y >> 16));
  const float xm = t0 > 0 ? bf2f(seq[t0 - 1]) : 0.f;
  const float xp = t0 + 4 < L ? bf2f(seq[t0 + 4]) : 0.f;
  o[0] = w0 * xm + w1 * x0 + w2 * x1 + sb;
  o[1] = w0 * x0 + w1 * x1 + w2 * x2 + sb;
  o[2] = w0 * x1 + w1 * x2 + w2 * x3 + sb;
  o[3] = w0 * x2 + w1 * x3 + w2 * xp + sb;
}

template <bool SAMPLE>
DI void hyena_item(const Params& p, int l, int c, char* smem) {
  constexpr int L = SAMPLE ? 4096 : 256, NB = SAMPLE ? 4 : 16, LGNB = SAMPLE ? 2 : 4;
  constexpr int NIT = 32 / NB, PADB = NIT - 1, NI = L / 32;
  constexpr int LP = L + 2 * PADB * 32 + 80;
  constexpr int NTW = SAMPLE ? 4 : 1;
  constexpr int RL = 2 * L + 16;
  constexpr int ROW0 = SAMPLE ? TP : 0;
  const int tid = tidx(), lane = tid & 63, w = tid >> 6, h = lane >> 5, c32 = lane & 31;
  u16* U = (u16*)smem;
  u16* R = U + NB * LP;
  float* red = (float*)(R + RL);
  const u16* hyT = (const u16*)(p.ws + O_HYT);
  const u16* hyf = (const u16*)(p.ws + O_HYF + (SAMPLE ? 0 : SZ_HYF_S));
  const float* sw = lnd(p.hy_short_w) + (size_t)l * 3 * 768;
  const float* sbp = lnd(p.hy_short_b) + l * 768;
  __syncthreads();
  for (int i = tid; i < NB * PADB * 32 * 2; i += 256) {
    const int bb = i / (PADB * 64), r = i % (PADB * 64);
    const int off = r < PADB * 32 ? r : (PADB * 32 + L + (r - PADB * 32));
    U[bb * LP + off] = 0;
  }
  {
    const float w0 = sw[c], w1 = sw[768 + c], w2 = sw[1536 + c], sb = sbp[c];
    for (int gi = tid; gi < NB * L / 4; gi += 256) {
      const int bb = gi / (L / 4), t0 = (gi % (L / 4)) * 4;
      float o[4];
      shortconv4(hyT + (size_t)c * TT + ROW0 + bb * L, t0, L, w0, w1, w2, sb, o);
      uint2 pk;
      pk.x = pack2(o[0], o[1]);
      pk.y = pack2(o[2], o[3]);
      *(uint2*)(U + bb * LP + PADB * 32 + t0) = pk;
    }
  }
  const int b_n = c32 & (NB - 1), il = c32 >> LGNB;
  f32x16 acc[NTW];
#pragma unroll 1
  for (int o = 0; o < 2; ++o) {
    const u16* F0 = hyf + ((size_t)((o * 2 + 0) * 256 + c)) * L;
    const u16* F1 = hyf + ((size_t)((o * 2 + 1) * 256 + c)) * L;
    float ps = 0.f;
#pragma unroll 4
    for (int i = tid; i < L; i += 256) {
      const u16 a0 = F0[i], a1 = F1[i];
      ps += fabsf(bf2f(a0)) + (i >= 1 ? fabsf(bf2f(a1)) : 0.f);
    }
    ps = wave_sum(ps);
    if (lane == 0) red[w] = ps;
    __syncthreads();
    const float inorm = 1.f / (red[0] + red[1] + red[2] + red[3]);
    for (int yb = tid; yb < RL; yb += 1024) {
      u16 raw[4];
#pragma unroll
      for (int u = 0; u < 4; ++u) {
        const int lag = L - (yb + u * 256), al = lag < 0 ? -lag : lag;
        const u16* src = lag >= 0 ? F0 : F1;
        raw[u] = src[al < L ? al : L - 1];
      }
#pragma unroll
      for (int u = 0; u < 4; ++u) {
        const int y = yb + u * 256, lag = L - y, al = lag < 0 ? -lag : lag;
        if (y < RL) R[y] = al < L ? f2bf(bf2f(raw[u]) * inorm) : (u16)0;
      }
    }
    __syncthreads();
    const int i0w = (w * NTW) * NIT;
    const int dlo = i0w - (NI - 1), dhi = i0w + (NTW - 1) * NIT + NIT - 1;
    const unsigned* Rdw = (const unsigned*)R;
#pragma unroll 1
    for (int rep_ = 0; rep_ < PQ_CONV; ++rep_) {
#pragma unroll
    for (int k = 0; k < NTW; ++k)
#pragma unroll
      for (int i = 0; i < 16; ++i) acc[k][i] = 0.f;
#pragma unroll 1
    for (int d = dlo; d <= dhi; ++d) {
#pragma unroll
      for (int kk = 0; kk < 2; ++kk) {
        const int k0 = kk * 16 + h * 8;
        const int y0 = L - (32 * d + c32 - k0);
        const int q = y0 >> 1;
        const unsigned sh = (y0 & 1) * 16;
        const unsigned d0 = Rdw[q], d1 = Rdw[q + 1], d2 = Rdw[q + 2], d3 = Rdw[q + 3], d4 = Rdw[q + 4];
        const uint4 a4 = make_uint4(__builtin_amdgcn_alignbit(d1, d0, sh), __builtin_amdgcn_alignbit(d2, d1, sh),
                                    __builtin_amdgcn_alignbit(d3, d2, sh), __builtin_amdgcn_alignbit(d4, d3, sh));
        const bf16x8 af = __builtin_bit_cast(bf16x8, a4);
#pragma unroll
        for (int k = 0; k < NTW; ++k) {
          int j = i0w + k * NIT + il - d;
          j = j < -PADB ? -PADB : (j > NI - 1 + PADB ? NI - 1 + PADB : j);
          const bf16x8 bfr = *(const bf16x8*)(U + b_n * LP + (PADB + j) * 32 + k0);
          acc[k] = MFMA32(af, bfr, acc[k]);
        }
      }
    }
    }
    const int chx = 256 * (o + 1) + c;
    const float w0 = sw[chx], w1 = sw[768 + chx], w2 = sw[1536 + chx], sb = sbp[chx];
    const float bias = lnd(p.hy_bias)[(l * 2 + o) * 256 + c];
    const u16* xseq = hyT + (size_t)chx * TT + ROW0 + b_n * L;
    if (o == 0) __syncthreads();
#pragma unroll
    for (int k = 0; k < NTW; ++k) {
      const int ib = i0w + k * NIT + il;
#pragma unroll
      for (int g4 = 0; g4 < 4; ++g4) {
        __builtin_amdgcn_sched_barrier(0);
        const int t0 = ib * 32 + 8 * g4 + 4 * h;
        float xg[4];
        shortconv4(xseq, t0, L, w0, w1, w2, sb, xg);
        u16* up = U + b_n * LP + PADB * 32 + t0;
        const uint2 uu = *(const uint2*)up;
        const float u0 = bf2f((u16)(uu.x & 0xffff)), u1 = bf2f((u16)(uu.x >> 16)), u2 = bf2f((u16)(uu.y & 0xffff)), u3 = bf2f((u16)(uu.y >> 16));
        const float y0 = xg[0] * (acc[k][4 * g4] + u0 * bias), y1 = xg[1] * (acc[k][4 * g4 + 1] + u1 * bias);
        const float y2 = xg[2] * (acc[k][4 * g4 + 2] + u2 * bias), y3 = xg[3] * (acc[k][4 * g4 + 3] + u3 * bias);
        if (o == 0) {
          uint2 pk;
          pk.x = pack2(y0, y1);
          pk.y = pack2(y2, y3);
          *(uint2*)up = pk;
        } else {
          u16* mix = (u16*)(p.ws + O_HMIX);
          const size_t rowb = (size_t)(ROW0 + b_n * L + t0);
          mix[(rowb + 0) * 1024 + 256 + c] = f2bf(y0);
          mix[(rowb + 1) * 1024 + 256 + c] = f2bf(y1);
          mix[(rowb + 2) * 1024 + 256 + c] = f2bf(y2);
          mix[(rowb + 3) * 1024 + 256 + c] = f2bf(y3);
        }
      }
    }
    __syncthreads();
  }
}

template <int MODE>
DI void hgrn_item(const Params& p, int l, int item, char* smem) {
  const int tid = tidx(), lane = tid & 63, w = tid >> 6;
  int seq, head, dir, row0, sidj = 0;
  if (MODE == 0) { seq = item >> 3; head = (item >> 1) & 3; dir = item & 1; row0 = seq * 256; }
  else {
    const int j = item & 15, sid = item >> 4;
    seq = sid >> 3; head = (sid >> 1) & 3; dir = sid & 1;
    row0 = TP + seq * 4096 + (dir ? 15 - j : j) * 256;
    sidj = item;
  }
  constexpr int NC = 4;
  constexpr bool FULL = MODE != 1;
  constexpr int LD = 72;
  u16* Qm = (u16*)smem;
  u16* Km = Qm + 64 * LD;
  u16* Qb = Km + 64 * LD;
  u16* Klt = Qb + 64 * LD;
  u16* Vt = Klt + 64 * LD;
  u16* St = Vt + 64 * LD;
  float* ebl = (float*)(St + 64 * LD);
  float* tot = ebl + 64;
  float* lfs = (float*)smem;
  u16* Att = Qm;
  const u16* hg = (const u16*)(p.ws + O_HG);
  u16* hgo = (u16*)(p.ws + O_HGO) + (size_t)dir * TT * 256;
  const float* lbv = (const float*)(p.ws + O_LBV) + (l * 2 + dir) * 256 + head * 64;
  f32x4 st[4];
  const int er = 16 * w + (lane >> 4) * 4, dc = lane & 15;
#pragma unroll
  for (int dt = 0; dt < 4; ++dt)
#pragma unroll
    for (int r = 0; r < 4; ++r) {
      float v = 0.f;
      if (MODE == 2) v = ((const float*)(p.ws + O_SLOC))[(size_t)sidj * 4096 + (dt * 16 + dc) * 64 + er + r];
      st[dt][r] = v;
    }
  __syncthreads();
  float* lsumd = tot + 256;
  if (MODE == 1 && tid < 64) lsumd[tid] = 0.f;
#pragma unroll
  for (int dt = 0; dt < 4; ++dt)
#pragma unroll
    for (int r = 0; r < 4; ++r) St[(er + r) * LD + dt * 16 + dc] = f2bf(st[dt][r]);
  const int tau = tid >> 2, dseg = (tid & 3) * 16;
  float lbr[16];
#pragma unroll
  for (int j = 0; j < 16; ++j) lbr[j] = lbv[dseg + j];
  uint4 gq[2], gv[2], gz[2];
  auto gload = [&](int ci) {
    const int cidx = dir == 0 ? ci : NC - 1 - ci;
    const int t = cidx * 64 + (dir == 0 ? tau : 63 - tau);
    const u16* base = hg + (size_t)(row0 + t) * 1280 + head * 64 + dseg;
    gq[0] = *(const uint4*)(base); gq[1] = *(const uint4*)(base + 8);
    gv[0] = *(const uint4*)(base + 256); gv[1] = *(const uint4*)(base + 256 + 8);
    const int zo = dir == 0 ? 512 : 768;
    gz[0] = *(const uint4*)(base + zo); gz[1] = *(const uint4*)(base + zo + 8);
  };
  gload(0);
#pragma unroll 1
  for (int ci = 0; ci < NC; ++ci) {
    const int cidx = dir == 0 ? ci : NC - 1 - ci;
    float qv[16], kv[16], lf[16];
    {
      const unsigned qq[8] = {gq[0].x, gq[0].y, gq[0].z, gq[0].w, gq[1].x, gq[1].y, gq[1].z, gq[1].w};
      const unsigned zz[8] = {gz[0].x, gz[0].y, gz[0].z, gz[0].w, gz[1].x, gz[1].y, gz[1].z, gz[1].w};
      const unsigned vv[8] = {gv[0].x, gv[0].y, gv[0].z, gv[0].w, gv[1].x, gv[1].y, gv[1].z, gv[1].w};
#pragma unroll
      for (int j = 0; j < 16; ++j) {
        const float qr = bf2f((u16)((qq[j >> 1] >> ((j & 1) * 16)) & 0xffff));
        const float zr = bf2f((u16)((zz[j >> 1] >> ((j & 1) * 16)) & 0xffff));
        qv[j] = siluf_(qr);
        const float sg = frcp_(1.f + __expf(-zr));
        const float f = lbr[j] + (1.f - lbr[j]) * sg;
        kv[j] = 1.f - f;
        lf[j] = __logf(f);
        Vt[(dseg + j) * LD + tau] = (u16)((vv[j >> 1] >> ((j & 1) * 16)) & 0xffff);
        lfs[tau * 64 + dseg + j] = lf[j];
      }
    }
    __syncthreads();
    if (ci + 1 < NC) gload(ci + 1);
    {
      const int d = tid & 63, part = tid >> 6;
      float run[16];
      float a = 0.f;
#pragma unroll
      for (int j = 0; j < 16; ++j) {
        a += lfs[(part * 16 + j) * 64 + d];
        run[j] = a;
      }
      tot[part * 64 + d] = a;
      __syncthreads();
      float off = 0.f;
      for (int pp = 0; pp < part; ++pp) off += tot[pp * 64 + d];
#pragma unroll
      for (int j = 0; j < 16; ++j) lfs[(part * 16 + j) * 64 + d] = run[j] + off;
    }
    __syncthreads();
    float bb[16], bm[16], bl[16];
#pragma unroll
    for (int j = 0; j < 16; ++j) {
      bb[j] = lfs[tau * 64 + dseg + j];
      bm[j] = lfs[31 * 64 + dseg + j];
      bl[j] = lfs[63 * 64 + dseg + j];
    }
    __syncthreads();
#pragma unroll
    for (int j = 0; j < 16; j += 2) {
      if (FULL) {
        *(unsigned*)(Qm + tau * LD + dseg + j) = pack2(qv[j] * __expf(bb[j] - bm[j]), qv[j + 1] * __expf(bb[j + 1] - bm[j + 1]));
        *(unsigned*)(Km + tau * LD + dseg + j) = pack2(kv[j] * __expf(bm[j] - bb[j]), kv[j + 1] * __expf(bm[j + 1] - bb[j + 1]));
        *(unsigned*)(Qb + tau * LD + dseg + j) = pack2(qv[j] * __expf(bb[j]), qv[j + 1] * __expf(bb[j + 1]));
      }
      Klt[(dseg + j) * LD + tau] = f2bf(kv[j] * __expf(bl[j] - bb[j]));
      Klt[(dseg + j + 1) * LD + tau] = f2bf(kv[j + 1] * __expf(bl[j + 1] - bb[j + 1]));
    }
    if (tau == 63) {
#pragma unroll
      for (int j = 0; j < 16; ++j) {
        ebl[dseg + j] = __expf(bl[j]);
        if (MODE == 1) lsumd[dseg + j] += bl[j];
      }
    }
    __syncthreads();
    f32x4 at[4];
    if (FULL) {
      const int r16 = lane & 15, kq = (lane >> 4) * 8;
#pragma unroll
      for (int ct = 0; ct < 4; ++ct) {
        at[ct] = (f32x4){0.f, 0.f, 0.f, 0.f};
#pragma unroll
        for (int ks = 0; ks < 2; ++ks) {
          const bf16x8 a = *(const bf16x8*)(Qm + (16 * w + r16) * LD + ks * 32 + kq);
          const bf16x8 b = *(const bf16x8*)(Km + (16 * ct + r16) * LD + ks * 32 + kq);
          at[ct] = MFMA16(a, b, at[ct]);
        }
      }
    }
    if (FULL) {
      __syncthreads();
#pragma unroll
      for (int ct = 0; ct < 4; ++ct)
#pragma unroll
        for (int r = 0; r < 4; ++r) {
          const int trow = 16 * w + (lane >> 4) * 4 + r, scol = 16 * ct + (lane & 15);
          Att[trow * LD + scol] = scol <= trow ? f2bf(at[ct][r]) : (u16)0;
        }
      __syncthreads();
    }
    {
      const int r16 = lane & 15, kq = (lane >> 4) * 8;
#pragma unroll
      for (int ct = 0; ct < (FULL ? 4 : 0); ++ct) {
        f32x4 o = (f32x4){0.f, 0.f, 0.f, 0.f};
#pragma unroll
        for (int ks = 0; ks < 2; ++ks) {
          const bf16x8 a = *(const bf16x8*)(Att + (16 * w + r16) * LD + ks * 32 + kq);
          const bf16x8 b = *(const bf16x8*)(Vt + (16 * ct + r16) * LD + ks * 32 + kq);
          o = MFMA16(a, b, o);
        }
#pragma unroll
        for (int ks = 0; ks < 2; ++ks) {
          const bf16x8 a = *(const bf16x8*)(Qb + (16 * w + r16) * LD + ks * 32 + kq);
          const bf16x8 b = *(const bf16x8*)(St + (16 * ct + r16) * LD + ks * 32 + kq);
          o = MFMA16(a, b, o);
        }
#pragma unroll
        for (int r = 0; r < 4; ++r) {
          const int tl = 16 * w + (lane >> 4) * 4 + r;
          const int t = cidx * 64 + (dir == 0 ? tl : 63 - tl);
          hgo[(size_t)(row0 + t) * 256 + head * 64 + 16 * ct + (lane & 15)] = f2bf(o[r]);
        }
      }
#pragma unroll
      for (int dt = 0; dt < 4; ++dt) {
        const float sc = ebl[dt * 16 + (lane & 15)];
        f32x4 a4 = st[dt] * sc;
#pragma unroll
        for (int ks = 0; ks < 2; ++ks) {
          const bf16x8 a = *(const bf16x8*)(Vt + (16 * w + r16) * LD + ks * 32 + kq);
          const bf16x8 b = *(const bf16x8*)(Klt + (16 * dt + r16) * LD + ks * 32 + kq);
          a4 = MFMA16(a, b, a4);
        }
        st[dt] = a4;
      }
    }
    __syncthreads();
#pragma unroll
    for (int dt = 0; dt < 4; ++dt)
#pragma unroll
      for (int r = 0; r < 4; ++r) St[(er + r) * LD + dt * 16 + dc] = f2bf(st[dt][r]);
  }
  if (MODE == 0) {
#pragma unroll
    for (int dt = 0; dt < 4; ++dt)
#pragma unroll
      for (int r = 0; r < 4; ++r)
        p.out[OUT_HG + ((size_t)(((seq * 2 + l) * 2 + dir) * 4 + head) * 64 + (dt * 16 + dc)) * 64 + er + r] = st[dt][r];
  }
  if (MODE == 1) {
    float* sloc = (float*)(p.ws + O_SLOC) + (size_t)sidj * 4096;
#pragma unroll
    for (int dt = 0; dt < 4; ++dt)
#pragma unroll
      for (int r = 0; r < 4; ++r) sloc[(dt * 16 + dc) * 64 + er + r] = st[dt][r];
    if (tid < 64) ((float*)(p.ws + O_SDEC))[sidj * 64 + tid] = __expf(lsumd[tid]);
  }
}

DI void hgrn_scan_item(const Params& p, int l, int item) {
  const int idx = item * 256 + tidx();
  const int e = idx & 63, d = (idx >> 6) & 63, sid = idx >> 12;
  const int seq = sid >> 3, head = (sid >> 1) & 3, dir = sid & 1;
  float* sloc = (float*)(p.ws + O_SLOC) + (size_t)sid * 16 * 4096 + d * 64 + e;
  const float* sdec = (const float*)(p.ws + O_SDEC) + sid * 16 * 64 + d;
  float S = lnd(p.state_hgrn)[((size_t)(((seq * 2 + l) * 2 + dir) * 4 + head) * 64 + d) * 64 + e];
  float loc[16], dec[16];
#pragma unroll
  for (int j = 0; j < 16; ++j) {
    loc[j] = sloc[(size_t)j * 4096];
    dec[j] = sdec[j * 64];
  }
#pragma unroll
  for (int j = 0; j < 16; ++j) {
    sloc[(size_t)j * 4096] = S;
    S = dec[j] * S + loc[j];
  }
}

DI void hgrn_fin_item(const Params& p, int l, int item) {
  const int tid = tidx(), lane = tid & 63, w = tid >> 6;
  const int row = item * 4 + w;
  const u16* hgo = (const u16*)(p.ws + O_HGO);
  const u16* hg = (const u16*)(p.ws + O_HG);
  u16* mix = (u16*)(p.ws + O_HMIX);
  const int c0 = lane * 4;
  const uint2 a = *(const uint2*)(hgo + (size_t)row * 256 + c0), b = *(const uint2*)(hgo + ((size_t)TT + row) * 256 + c0);
  const uint2 gg = *(const uint2*)(hg + (size_t)row * 1280 + 1024 + c0);
  float o[4];
  o[0] = bf2f((u16)(a.x & 0xffff)) + bf2f((u16)(b.x & 0xffff));
  o[1] = bf2f((u16)(a.x >> 16)) + bf2f((u16)(b.x >> 16));
  o[2] = bf2f((u16)(a.y & 0xffff)) + bf2f((u16)(b.y & 0xffff));
  o[3] = bf2f((u16)(a.y >> 16)) + bf2f((u16)(b.y >> 16));
  float ss = o[0] * o[0] + o[1] * o[1] + o[2] * o[2] + o[3] * o[3];
#pragma unroll
  for (int m = 8; m >= 1; m >>= 1) ss += __shfl_xor(ss, m);
  const float r = rsqrtf(ss * (1.f / 64.f) + LN_EPS);
  const float* ng = lnd(p.hgrn_norm_g) + l * 64 + (c0 & 63);
  const float g0 = siluf_(bf2f((u16)(gg.x & 0xffff))), g1 = siluf_(bf2f((u16)(gg.x >> 16)));
  const float g2 = siluf_(bf2f((u16)(gg.y & 0xffff))), g3 = siluf_(bf2f((u16)(gg.y >> 16)));
  uint2 pk;
  pk.x = pack2(o[0] * r * ng[0] * g0, o[1] * r * ng[1] * g1);
  pk.y = pack2(o[2] * r * ng[2] * g2, o[3] * r * ng[3] * g3);
  *(uint2*)(mix + (size_t)row * 1024 + 512 + c0) = pk;
}

DI void s5scan_item(const Params& p, int l, int item) {
  const int gid = item * 256 + tidx();
  const int pp = gid & 63, g = (gid >> 6) & 15, dir = (gid >> 10) & 1, seq = gid >> 11;
  const bool sample = seq >= 16;
  const int nch = sample ? 128 : 8;
  const int ch0 = sample ? 128 + (seq - 16) * 128 : seq * 8;
  const float2 aT = ((const float2*)(p.ws + O_AT))[(dir * 16 + g) * 64 + pp];
  const float* xloc = (const float*)(p.ws + O_XLOC);
  u16* bcat = (u16*)(p.ws + O_BCAT);
  float xr = 0.f, xi = 0.f;
  if (sample) {
    const float* s0 = lnd(p.state_s5) + ((size_t)((((seq - 16) * 2 + l) * 2 + dir) * 16 + g) * 64 + pp) * 2;
    xr = s0[0];
    xi = s0[1];
  }
#pragma unroll 1
  for (int i0 = 0; i0 < nch; i0 += 8) {
    float2 xl[8];
#pragma unroll
    for (int j = 0; j < 8; ++j) {
      const int i = i0 + j, ch = dir == 0 ? ch0 + i : ch0 + nch - 1 - i;
      xl[j] = *(const float2*)(xloc + ((size_t)(g * NCH32 + ch)) * 256 + dir * 128 + pp * 2);
    }
#pragma unroll
    for (int j = 0; j < 8; ++j) {
      const int i = i0 + j, ch = dir == 0 ? ch0 + i : ch0 + nch - 1 - i;
      *(unsigned*)(bcat + ((size_t)(g * NCH32 + ch)) * 768 + 512 + dir * 128 + pp * 2) = pack2(xr, xi);
      const float nr = aT.x * xr - aT.y * xi + xl[j].x, ni = aT.x * xi + aT.y * xr + xl[j].y;
      xr = nr;
      xi = ni;
    }
  }
  if (!sample) {
    float* o = p.out + OUT_S5 + ((size_t)(((seq * 2 + l) * 2 + dir) * 16 + g) * 64 + pp) * 2;
    o[0] = xr;
    o[1] = xi;
  }
}

#define XB_TMO 128
#define XB_XCNT(j) (256 + 64 * (j))
#define XB_XSUB(j) (1280 + 64 * (j))
#define XB_XGEN(j) (2304 + 64 * (j))
#define XB_TOP 3328
#define XB_TOPGEN 3392
#define XCD_BAR_WORDS 3456
#define XB_SPIN_CAP (1u << 22)
#define LAS __attribute__((address_space(3)))
DI unsigned xb_ld(unsigned* p) { return __hip_atomic_load(p, __ATOMIC_RELAXED, __HIP_MEMORY_SCOPE_AGENT); }
DI unsigned xb_add(unsigned* p, unsigned v) { return __hip_atomic_fetch_add(p, v, __ATOMIC_RELAXED, __HIP_MEMORY_SCOPE_AGENT); }
DI unsigned xb_xcc_id() { return (unsigned)__builtin_amdgcn_s_getreg((3 << 11) | 20) & 0xFu; }
#define XB_SPIN(cond, bar)                                                         \
  do {                                                                             \
    unsigned _sp = 0;                                                              \
    while (cond) {                                                                 \
      __builtin_amdgcn_s_sleep(1);                                                 \
      if ((++_sp & 255u) == 0u) {                                                  \
        if (xb_ld(&(bar)[XB_TMO])) break;                                          \
        if (_sp > XB_SPIN_CAP) { atomicAdd(&(bar)[XB_TMO], 1u); break; }           \
      }                                                                            \
    }                                                                              \
  } while (0)
DI void xcd_barrier_complete(unsigned* bar, unsigned x, unsigned& nloc, unsigned& nx) {
  const unsigned G = gridDim.x;
  unsigned sum, cnt, mine, sp = 0u;
  for (;;) {
    sum = 0u; cnt = 0u; mine = 0u;
#pragma unroll
    for (unsigned j = 0; j < 16; ++j) {
      const unsigned c = xb_ld(&bar[XB_XCNT(j)]);
      sum += c;
      cnt += (c > 0u) ? 1u : 0u;
      mine = (j == x) ? c : mine;
    }
    if (sum == G) break;
    __builtin_amdgcn_s_sleep(1);
    if ((++sp & 255u) == 0u) {
      if (xb_ld(&bar[XB_TMO])) break;
      if (sp > XB_SPIN_CAP) { atomicAdd(&bar[XB_TMO], 1u); break; }
    }
  }
  nloc = mine > 0u ? mine : 1u;
  nx = cnt > 0u ? cnt : 1u;
}
DI void xcd_barrier(unsigned* bar, volatile LAS unsigned* st) {
  asm volatile("s_waitcnt vmcnt(0)" ::: "memory");
  __syncthreads();
  if (threadIdx.x == 0) {
    const unsigned x = xb_xcc_id();
    __builtin_amdgcn_s_waitcnt(0);
    unsigned nloc = st[0], nx = st[1];
    if (nloc == 0u) {
      xcd_barrier_complete(bar, x, nloc, nx);
      st[0] = nloc;
      st[1] = nx;
    }
    const unsigned old = xb_add(&bar[XB_XSUB(x)], 1u);
    const unsigned gen = old / nloc;
    if (old + 1u == (gen + 1u) * nloc) {
      __builtin_amdgcn_fence(__ATOMIC_RELEASE, "agent");
      asm volatile("s_waitcnt vmcnt(0)" ::: "memory");
      const unsigned og = xb_add(&bar[XB_TOP], 1u);
      const unsigned tg = og / nx;
      if (og + 1u == (tg + 1u) * nx) xb_add(&bar[XB_TOPGEN], 1u);
      else XB_SPIN(xb_ld(&bar[XB_TOPGEN]) == tg, bar);
      __builtin_amdgcn_fence(__ATOMIC_ACQUIRE, "agent");
      xb_add(&bar[XB_XGEN(x)], 1u);
      asm volatile("s_waitcnt vmcnt(0)" ::: "memory");
    } else {
      XB_SPIN(xb_ld(&bar[XB_XGEN(x)]) == gen, bar);
      __builtin_amdgcn_fence(__ATOMIC_ACQUIRE, "agent");
      asm volatile("s_waitcnt vmcnt(0)" ::: "memory");
    }
  }
  __syncthreads();
}

constexpr int SMEM_BYTES = 57344;
constexpr int N_PHASES = 22;
constexpr int PREP_N = CV_TOTAL + 272 + 512;

template <class F>
DI void xcd_tiles(unsigned* q, int n_tm, int n_tn, char* smem, F&& f) {
  volatile LAS unsigned* qslot = (volatile LAS unsigned*)(smem + SMEM_BYTES - 8);
  const int tmp = n_tm >> 3, R = tmp * n_tn;
  const int x0 = (int)(xb_xcc_id() & 7u);
  const bool leader = tidx() == 0;
  int dx = 0, raw = 0;
  if (leader) raw = (int)xb_add(q + x0 * 16, 1u);
  for (;;) {
    __syncthreads();
    if (leader) {
      while (raw >= R && dx < 8) {
        ++dx;
        if (dx < 8) raw = (int)xb_add(q + ((x0 + dx) & 7) * 16, 1u);
      }
      *qslot = dx < 8 ? (unsigned)(((x0 + dx) & 7) * R + raw) : 0xffffffffu;
    }
    __syncthreads();
    const int code = __builtin_amdgcn_readfirstlane((int)*qslot);
    if (code < 0) break;
    const int x = code / R, i = code - x * R;
    const int tn = i / tmp, tm = x * tmp + (i - tn * tmp);
    f(tm, tn, [&]() { if (leader) raw = (int)xb_add(q + x * 16, 1u); });
  }
}

DI void prep_item(const Params& p, int l, int item, char* smem) {
  if (item < 512) return s5prep_item(p, l, item, smem);
  item -= 512;
  if (item < 272) return hyf_item(p, l, item, smem);
  item -= 272;
  convert_item(p, l, item, smem);
}

DI void run_phase(const Params& pin, int ph, char* smem) {
  Params p = pin;
  asm volatile("" : "+s"(p.ws), "+s"(p.out));
  const int l = ph < 2 ? 0 : (ph - 2) / 10;
  const int sub = ph < 2 ? ph : 2 + (ph - 2) % 10;
  int nb = gridDim.x, b0 = blockIdx.x;
  asm volatile("" : "+s"(nb), "+s"(b0));
  const float* mod = (const float*)(p.ws + O_MOD);
  unsigned* gq = (unsigned*)(p.ws + O_BAR) + 4096 + ph * 256;
  const u16* hmix = (const u16*)(p.ws + O_HMIX);
  const float* xinP = l == 0 ? lnd(p.x_prompt) : p.out;
  const float* xinS = l == 0 ? lnd(p.x_sample) : p.out + (size_t)TP * 1024;
  switch (sub) {
    case 0: {
      const int n = 192 + 256 + 1 + PREP_N;
      for (int it = b0; it < n; it += nb) {
        if (it < 192) mod_item(p, it, smem);
        else if (it < 448) rope_item(p, it - 192);
        else if (it < 449) lbv_item(p);
        else prep_item(p, 0, it - 449, smem);
      }
    } break;
    case 1: {
      for (int it = b0; it < TT / 8; it += nb) ln_item(p, it, lnd(p.x_prompt), lnd(p.x_sample), nullptr, nullptr, mod, 0, 1);
    } break;
    case 2: {
      EpiWin epi{p, l};
      xcd_tiles(gq, 160, 12, smem, [&](int tm, int tn, auto hook) {
        gemm_tile_w(hmix, 1024, TT, (const u16*)(p.ws + O_WT_IN), 1024, 3072, 1024, tm, tn, epi, smem, hook);
      });
      for (int it = b0; it < 512; it += nb) s5expand_item(p, l, it);
    } break;
    case 3: {
      unsigned* qctr = (unsigned*)(p.ws + O_BAR) + 3584 + l * 64;
      volatile LAS unsigned* qslot = (volatile LAS unsigned*)(smem + SMEM_BYTES - 8);
      constexpr int N0 = 768, N1 = N0 + 512, N2 = N1 + 128, N3 = N2 + 128, N4 = N3 + 256, N5 = N4 + 160;
      for (;;) {
        __syncthreads();
        if (tidx() == 0) *qslot = xb_add(qctr, 1u);
        __syncthreads();
        const int it = __builtin_amdgcn_readfirstlane((int)*qslot);
        if (it >= N5) break;
        int type, idx;
        if (it < N0) {
          type = it < 256 ? 1 : 0;
          idx = it < 256 ? it : it - 256;
        } else if (it < N1) { type = 2; idx = it - N0; }
        else if (it < N2) { type = 3; idx = it - N1; }
        else if (it < N3) { type = 0; idx = 512 + it - N2; }
        else if (it < N4) { type = 4; idx = it - N3; }
        else { type = 5; idx = it - N4; }
        type = __builtin_amdgcn_readfirstlane(type);
        idx = __builtin_amdgcn_readfirstlane(idx);
        switch (type) {
          case 0:
#pragma unroll 1
            for (int r_ = 0; r_ < PQ_ATT; ++r_) { __syncthreads(); attn_item(p, l, idx, smem); }
            break;
          case 1:
#pragma unroll 1
            for (int r_ = 0; r_ < PQ_HY; ++r_) hyena_item<true>(p, l, idx, smem);
            break;
          case 2:
#pragma unroll 1
            for (int r_ = 0; r_ < PQ_H1; ++r_) hgrn_item<1>(p, l, idx, smem);
            break;
          case 3: hgrn_item<0>(p, l, idx, smem); break;
          case 4: hyena_item<false>(p, l, idx, smem); break;
          default: {
            const int g = idx / 10, r = idx % 10;
            EpiS5E epi{p, g};
            gemm_tile((const u16*)(p.ws + O_BCAT) + (size_t)g * NCH32 * 768, 768, NCH32,
                      (const u16*)(p.ws + O_EMAT) + (size_t)g * 256 * 512, 512, 256, 512, r >> 1, r & 1, epi, smem);
          }
        }
      }
    } break;
    case 4: {
      const int n = 160 + 512;
      for (int it = b0; it < n; it += nb) {
        if (it < 160) s5scan_item(p, l, it);
        else hgrn_scan_item(p, l, it - 160);
      }
    } break;
    case 5: {
      for (int it = b0; it < 512; it += nb) hgrn_item<2>(p, l, it, smem);
      for (int it = b0; it < 16 * 20; it += nb) {
        const int g = it / 20, r = it % 20;
        EpiS5Y epi{p, g};
        gemm_tile((const u16*)(p.ws + O_ACAT) + (size_t)g * 512 * 768, 768, 512,
                  (const u16*)(p.ws + O_BCAT) + (size_t)g * NCH32 * 768, 768, NCH32, 768, r / 5, r % 5, epi, smem);
      }
    } break;
    case 6: {
      EpiGlu epi{p, l};
      for (int it = b0; it < 160 * 2; it += nb)
        gemm_tile((const u16*)(p.ws + O_ZS5), 256, TT, (const u16*)(p.ws + O_WT_GLU), 256, 256, 256, it >> 1, it & 1, epi, smem);
      for (int it = b0; it < TT / 4; it += nb) hgrn_fin_item(p, l, it);
    } break;
    case 7: {
      EpiRes epi{p, xinP, xinS, mod + (size_t)l * 5 * 6144 + 2 * 1024};
      xcd_tiles(gq, 160, 8, smem, [&](int tm, int tn, auto hook) {
        gemm_tile(hmix, 1024, TT, (const u16*)(p.ws + O_WT_OUT), 1024, 1024, 1024, tm, tn, epi, smem, hook);
      });
    } break;
    case 8: {
      for (int it = b0; it < TT / 8; it += nb)
        ln_item(p, it, p.out, p.out + (size_t)TP * 1024, lnd(p.ln_g) + (l * 2 + 0) * 1024, lnd(p.ln_b) + (l * 2 + 0) * 1024,
                mod + (size_t)l * 5 * 6144, 3, 4);
    } break;
    case 9: {
      EpiFfnIn epi{p};
      xcd_tiles(gq, 160, 22, smem, [&](int tm, int tn, auto hook) {
        gemm_tile_w(hmix, 1024, TT, (const u16*)(p.ws + O_WT_FFI), 1024, 5632, 1024, tm, tn, epi, smem, hook);
      });
    } break;
    case 10: {
      EpiRes epi{p, p.out, p.out + (size_t)TP * 1024, mod + (size_t)l * 5 * 6144 + 5 * 1024};
      xcd_tiles(gq, 160, 8, smem, [&](int tm, int tn, auto hook) {
        gemm_tile((const u16*)(p.ws + O_ACT), 2816, TT, (const u16*)(p.ws + O_WT_FFO), 2816, 1024, 2816, tm, tn, epi, smem, hook);
      });
    } break;
    case 11: {
      const int n = TT / 8 + (l == 0 ? PREP_N : 0);
      for (int it = b0; it < n; it += nb) {
        if (it < TT / 8)
          ln_item(p, it, p.out, p.out + (size_t)TP * 1024, lnd(p.ln_g) + (l * 2 + 1) * 1024, lnd(p.ln_b) + (l * 2 + 1) * 1024,
                  l == 0 ? mod + (size_t)5 * 6144 : nullptr, 0, 1);
        else prep_item(p, 1, it - TT / 8, smem);
      }
    } break;
  }
}


#ifndef PROBE_CASE
#define PROBE_CASE 0
#endif
#ifndef EXTRA_BAR
#define EXTRA_BAR 0
#endif
#ifndef PROBE_REP
#define PROBE_REP 2
#endif
template <int PH>
DI void phase_seq(const Params& p, char* smem) {
  constexpr int sub_ = PH < 2 ? PH : 2 + (PH - 2) % 10;
  constexpr int reps_ = ((PROBE_CASE >> sub_) & 1) ? PROBE_REP : 1;
  run_phase(p, PH, smem);
  if constexpr (reps_ >= 2) run_phase(p, PH, smem);
  if constexpr (reps_ >= 3) run_phase(p, PH, smem);
  if constexpr (PH + 1 < N_PHASES) {
    unsigned* bar = (unsigned*)(p.ws + O_BAR);
    volatile LAS unsigned* st = (volatile LAS unsigned*)(smem + SMEM_BYTES - 16);
    if constexpr (PH == 0) {
      if (blockIdx.x == 0)
        for (int i = threadIdx.x; i < 16384; i += 256) bar[i] = 0u;
      if (threadIdx.x == 0) { st[0] = 0u; st[1] = 0u; }
      cg::this_grid().sync();
      if (threadIdx.x == 0) (void)xb_add(&bar[XB_XCNT(xb_xcc_id())], 1u);
    } else {
#pragma unroll
      for (int j_ = 0; j_ < 1 + EXTRA_BAR; ++j_) xcd_barrier(bar, st);
    }
    phase_seq<PH + 1>(p, smem);
  }
}

__global__ void __launch_bounds__(256, 2) k_mega(Params p) {
  __shared__ __attribute__((aligned(16))) char smem[SMEM_BYTES];
  phase_seq<0>(p, smem);
}

__global__ void __launch_bounds__(256, 2) k_phase(Params p, int ph) {
  __shared__ __attribute__((aligned(16))) char smem[SMEM_BYTES];
  run_phase(p, ph, smem);
}

extern "C" void kernel_launch(void* const* d_in, const int* in_sizes, int n_in, void* d_out, int out_size, void* d_ws,
                              size_t ws_size, hipStream_t stream) {
  Params p{};
  const float** pp = (const float**)&p;
  for (int i = 0; i < 37; ++i) pp[i] = (const float*)d_in[i];
  p.out = (float*)d_out;
  p.ws = (char*)d_ws;
  if (ws_size < WS_TOTAL) fprintf(stderr, "workspace too small: %zu < %zu\n", ws_size, (size_t)WS_TOTAL);
#if MULTI
  for (int ph = 0; ph < N_PHASES; ++ph) hipLaunchKernelGGL(k_phase, dim3(512), dim3(256), 0, stream, p, ph);
#else
  static int grid_blocks = 0;
  if (!grid_blocks) {
    int dev = 0, cus = 0, per_cu = 0;
    hipGetDevice(&dev);
    hipDeviceGetAttribute(&cus, hipDeviceAttributeMultiprocessorCount, dev);
    (void)hipOccupancyMaxActiveBlocksPerMultiprocessor(&per_cu, k_mega, 256, 0);
    if (per_cu > 2) per_cu = 2;
    grid_blocks = cus * per_cu;
  }
  void* args[] = {&p};
  hipError_t e = hipLaunchCooperativeKernel((void*)k_mega, dim3(grid_blocks), dim3(256), args, 0, stream);
  if (e != hipSuccess) fprintf(stderr, "cooperative launch failed: %s (grid %d)\n", hipGetErrorString(e), grid_blocks);
#endif
}
```

```cpp
#include <hip/hip_runtime.h>
#include <hip/hip_cooperative_groups.h>
#include <stdint.h>
#include <stdio.h>
namespace cg = cooperative_groups;

#ifndef MULTI
#define MULTI 0
#endif

#ifndef PQ_ATT
#define PQ_ATT 1
#endif
#ifndef PQ_CONV
#define PQ_CONV 1
#endif
#ifndef PQ_HY
#define PQ_HY 1
#endif
#ifndef PQ_H1
#define PQ_H1 1
#endif
#define DI __device__ __forceinline__
typedef unsigned short u16;
typedef __attribute__((ext_vector_type(8))) short bf16x8;
typedef __attribute__((ext_vector_type(4))) float f32x4;
typedef __attribute__((ext_vector_type(16))) float f32x16;
typedef __bf16 bf2_t __attribute__((ext_vector_type(2)));
typedef float f2_t __attribute__((ext_vector_type(2)));
#define MFMA32(a, b, c) __builtin_amdgcn_mfma_f32_32x32x16_bf16((a), (b), (c), 0, 0, 0)
#define MFMA16(a, b, c) __builtin_amdgcn_mfma_f32_16x16x32_bf16((a), (b), (c), 0, 0, 0)

constexpr int TP = 4096, TS = 16384, TT = 20480;
constexpr int NCH32 = 640;
constexpr float LN_EPS = 1e-5f;
constexpr float ALPHA = 1.41421356237f;
constexpr float QSCALE = 0.17677669529f * 1.44269504089f;

constexpr size_t SZ_WT_IN = 3072ull * 1024 * 2, SZ_WT_OUT = 1024ull * 1024 * 2, SZ_WT_FFI = 5632ull * 1024 * 2,
                 SZ_WT_FFO = 1024ull * 2816 * 2, SZ_WT_GLU = 256ull * 256 * 2;
constexpr size_t O_WT_IN = 0;
constexpr size_t O_WT_OUT = O_WT_IN + SZ_WT_IN;
constexpr size_t O_WT_FFI = O_WT_OUT + SZ_WT_OUT;
constexpr size_t O_WT_FFO = O_WT_FFI + SZ_WT_FFI;
constexpr size_t O_WT_GLU = O_WT_FFO + SZ_WT_FFO;
constexpr size_t O_MOD = O_WT_GLU + SZ_WT_GLU;
constexpr size_t O_ROPE = O_MOD + 2ull * 5 * 6144 * 4;
constexpr size_t O_LBV = O_ROPE + 4096ull * 16 * 8;
constexpr size_t O_AT = O_LBV + 4096;
constexpr size_t O_BAR = O_AT + 16384;
constexpr size_t O_HYF = O_BAR + 65536;
constexpr size_t SZ_HYF_S = 4ull * 256 * 4096 * 2, SZ_HYF_P = 4ull * 256 * 256 * 2;
constexpr size_t O_ACAT = O_HYF + SZ_HYF_S + SZ_HYF_P;
constexpr size_t O_EMAT = O_ACAT + 16ull * 512 * 768 * 2;
constexpr size_t O_HMIX = O_EMAT + 16ull * 256 * 512 * 2;
constexpr size_t O_BIG = O_HMIX + (size_t)TT * 1024 * 2;
constexpr size_t O_QKV = O_BIG;
constexpr size_t O_HYT = O_QKV + (size_t)TT * 768 * 2;
constexpr size_t O_HG = O_HYT + (size_t)TT * 768 * 2;
constexpr size_t O_ACT = O_BIG;
constexpr size_t O_ZS5 = O_BIG;
constexpr size_t O_BCAT = O_BIG + (size_t)TT * 2816 * 2;
constexpr size_t O_XLOC = O_BCAT + 16ull * NCH32 * 768 * 2;
constexpr size_t O_HGO = O_XLOC + 16ull * NCH32 * 256 * 4;
constexpr size_t O_SLOC = O_HGO + 2ull * TT * 256 * 2;
constexpr size_t O_SDEC = O_SLOC + 32ull * 16 * 4096 * 4;
constexpr size_t O_KTAB = O_SDEC + 32ull * 16 * 64 * 4;
constexpr size_t WS_TOTAL = O_KTAB + 16ull * 2 * 32 * 256 * 4;

constexpr size_t OUT_K = (size_t)TT * 1024;
constexpr size_t OUT_V = OUT_K + 16ull * 2 * 256 * 256;
constexpr size_t OUT_HG = OUT_V + 16ull * 2 * 256 * 256;
constexpr size_t OUT_S5 = OUT_HG + 16ull * 2 * 2 * 4 * 4096;

struct Params {
  const float *x_prompt, *x_sample, *c, *cache_k, *cache_v, *state_hgrn, *state_s5, *c_ctx, *w_mod, *b_mod, *ln_g, *ln_b,
      *w_in, *w_out, *diff_lambda, *diff_subln_g, *hy_short_w, *hy_short_b, *hy_w1, *hy_b1, *hy_w2, *hy_b2, *hy_w3, *hy_freq,
      *hy_bias, *hgrn_lb, *hgrn_norm_g, *s5_lre, *s5_lim, *s5_b, *s5_c, *s5_logdt, *s5_d, *s5_glu_w, *s5_glu_b, *w_ffi, *w_ffo;
  float* out;
  char* ws;
};

DI int tidx() {
  int t = threadIdx.x;
  asm volatile("" : "+v"(t));
  return t;
}
template <class T>
DI T* lnd(T* x) {
  asm volatile("" : "+s"(x));
  return x;
}
DI float bf2f(u16 h) { return __uint_as_float(((unsigned)h) << 16); }
DI unsigned pack2(float a, float b) {
  f2_t v = {a, b};
  bf2_t r = __builtin_convertvector(v, bf2_t);
  return __builtin_bit_cast(unsigned, r);
}
DI u16 f2bf(float x) { return (u16)(pack2(x, 0.f) & 0xffffu); }
DI int crow(int i, int h) { return (i & 3) + 8 * (i >> 2) + 4 * h; }
#define DPPF_(val, ctrl, rm) __builtin_bit_cast(float, __builtin_amdgcn_update_dpp(0, __builtin_bit_cast(int, (val)), (ctrl), (rm), 0xF, false))
DI float wave_sum(float v) {
  v += DPPF_(v, 0xB1, 0xF);
  v += DPPF_(v, 0x4E, 0xF);
  v += DPPF_(v, 0x141, 0xF);
  v += DPPF_(v, 0x140, 0xF);
  v += DPPF_(v, 0x142, 0xA);
  v += DPPF_(v, 0x143, 0xC);
  return __builtin_bit_cast(float, __builtin_amdgcn_readlane(__builtin_bit_cast(int, v), 63));
}
DI float frcp_(float x) { return __builtin_amdgcn_rcpf(x); }
DI float sigmoidf_(float x) { return frcp_(1.f + __expf(-x)); }
DI float siluf_(float x) { return x * frcp_(1.f + __expf(-x)); }
DI float gelu_tanh(float x) {
  float u = 0.7978845608f * (x + 0.044715f * x * x * x);
  float t = 1.f - 2.f * frcp_(1.f + __expf(2.f * u));
  return 0.5f * x * (1.f + t);
}
DI int modvec(int row) { return row < TP ? 0 : 1 + ((row - TP) >> 12); }

struct NoHook {
  DI void operator()() const {}
};
template <class Epi, class Hook = NoHook>
DI void gemm_tile(const u16* __restrict__ A, int lda, int M, const u16* __restrict__ B, int ldb, int N, int K, int tm,
                  int tn, Epi& epi, char* smem, Hook hook = Hook()) {
  u16* As = (u16*)smem;
  u16* Bs = As + 128 * 72;
  const int tid = tidx(), lane = tid & 63, w = tid >> 6, wm = w >> 1, wn = w & 1;
  const int lr = tid >> 3, lc = (tid & 7) * 8;
  f32x16 acc[2][2];
#pragma unroll
  for (int a = 0; a < 2; ++a)
#pragma unroll
    for (int b = 0; b < 2; ++b)
#pragma unroll
      for (int i = 0; i < 16; ++i) acc[a][b][i] = 0.f;
  uint4 ra0, ra1, ra2, ra3, rb0, rb1, rb2, rb3;
  uint4 sa0, sa1, sa2, sa3, sb0, sb1, sb2, sb3;
  const u16* Ab = A + lc;
  const u16* Bb = B + lc;
  const int ar0 = tm * 128 + lr, br0 = tn * 128 + lr;
#define GL_A(q) (*(const uint4*)(Ab + (size_t)min(ar0 + 32 * (q), M - 1) * lda + kk))
#define GL_B(q) (*(const uint4*)(Bb + (size_t)min(br0 + 32 * (q), N - 1) * ldb + kk))
#define LOAD_R(KK) { const int kk = (KK); ra0 = GL_A(0); ra1 = GL_A(1); ra2 = GL_A(2); ra3 = GL_A(3); rb0 = GL_B(0); rb1 = GL_B(1); rb2 = GL_B(2); rb3 = GL_B(3); }
#define LOAD_S(KK) { const int kk = (KK); sa0 = GL_A(0); sa1 = GL_A(1); sa2 = GL_A(2); sa3 = GL_A(3); sb0 = GL_B(0); sb1 = GL_B(1); sb2 = GL_B(2); sb3 = GL_B(3); }
#define STORE_T(a0, a1, a2, a3, b0, b1, b2, b3)          \
  *(uint4*)(As + (lr + 0) * 72 + lc) = a0;               \
  *(uint4*)(As + (lr + 32) * 72 + lc) = a1;              \
  *(uint4*)(As + (lr + 64) * 72 + lc) = a2;              \
  *(uint4*)(As + (lr + 96) * 72 + lc) = a3;              \
  *(uint4*)(Bs + (lr + 0) * 72 + lc) = b0;               \
  *(uint4*)(Bs + (lr + 32) * 72 + lc) = b1;              \
  *(uint4*)(Bs + (lr + 64) * 72 + lc) = b2;              \
  *(uint4*)(Bs + (lr + 96) * 72 + lc) = b3;
#define COMPUTE_T()                                                                                                  \
  _Pragma("unroll") for (int ks = 0; ks < 4; ++ks) {                                                                 \
    bf16x8 af[2], bf[2];                                                                                             \
    _Pragma("unroll") for (int mi = 0; mi < 2; ++mi)                                                                 \
      af[mi] = *(const bf16x8*)(As + (wm * 64 + mi * 32 + (lane & 31)) * 72 + ks * 16 + (lane >> 5) * 8);            \
    _Pragma("unroll") for (int ni = 0; ni < 2; ++ni)                                                                 \
      bf[ni] = *(const bf16x8*)(Bs + (wn * 64 + ni * 32 + (lane & 31)) * 72 + ks * 16 + (lane >> 5) * 8);            \
    _Pragma("unroll") for (int mi = 0; mi < 2; ++mi)                                                                 \
      _Pragma("unroll") for (int ni = 0; ni < 2; ++ni) acc[mi][ni] = MFMA32(af[mi], bf[ni], acc[mi][ni]);            \
  }
  LOAD_R(0);
  LOAD_S(64);
  for (int k0 = 0; k0 < K; k0 += 128) {
    __syncthreads();
    STORE_T(ra0, ra1, ra2, ra3, rb0, rb1, rb2, rb3);
    __syncthreads();
    if (k0 + 128 < K) LOAD_R(k0 + 128);
    COMPUTE_T();
    __syncthreads();
    STORE_T(sa0, sa1, sa2, sa3, sb0, sb1, sb2, sb3);
    __syncthreads();
    if (k0 + 192 < K) LOAD_S(k0 + 192);
    COMPUTE_T();
  }
#undef GL_A
#undef GL_B
#undef LOAD_R
#undef LOAD_S
#undef STORE_T
#undef COMPUTE_T
  hook();
  epi(tm * 128 + wm * 64, tn * 128 + wn * 64, acc);
}

template <class Epi, class Hook = NoHook>
DI void gemm_tile_w(const u16* __restrict__ A, int lda, int M, const u16* __restrict__ B, int ldb, int N, int K, int tm,
                    int tn, Epi& epi, char* smem, Hook hook = Hook()) {
  u16* As = (u16*)smem;
  u16* Bs = As + 128 * 72;
  const int tid = tidx(), lane = tid & 63, w = tid >> 6, wm = w >> 1, wn = w & 1;
  const int lr = tid >> 3, lc = (tid & 7) * 8;
  f32x16 acc[2][2][2];
#pragma unroll
  for (int hh = 0; hh < 2; ++hh)
#pragma unroll
    for (int a = 0; a < 2; ++a)
#pragma unroll
      for (int b = 0; b < 2; ++b)
#pragma unroll
        for (int i = 0; i < 16; ++i) acc[hh][a][b][i] = 0.f;
  uint4 ra0, ra1, ra2, ra3, rb0, rb1, rb2, rb3, rb4, rb5, rb6, rb7;
  const u16* Ab = A + lc;
  const u16* Bb = B + lc;
  const int ar0 = tm * 128 + lr, br0 = tn * 256 + lr;
#define GL_A(q) (*(const uint4*)(Ab + (size_t)min(ar0 + 32 * (q), M - 1) * lda + kk))
#define GL_B(q) (*(const uint4*)(Bb + (size_t)min(br0 + 32 * (q), N - 1) * ldb + kk))
  {
    const int kk = 0;
    ra0 = GL_A(0); ra1 = GL_A(1); ra2 = GL_A(2); ra3 = GL_A(3);
    rb0 = GL_B(0); rb1 = GL_B(1); rb2 = GL_B(2); rb3 = GL_B(3);
    rb4 = GL_B(4); rb5 = GL_B(5); rb6 = GL_B(6); rb7 = GL_B(7);
  }
  for (int k0 = 0; k0 < K; k0 += 64) {
    __syncthreads();
    *(uint4*)(As + (lr + 0) * 72 + lc) = ra0;
    *(uint4*)(As + (lr + 32) * 72 + lc) = ra1;
    *(uint4*)(As + (lr + 64) * 72 + lc) = ra2;
    *(uint4*)(As + (lr + 96) * 72 + lc) = ra3;
    *(uint4*)(Bs + (lr + 0) * 72 + lc) = rb0;
    *(uint4*)(Bs + (lr + 32) * 72 + lc) = rb1;
    *(uint4*)(Bs + (lr + 64) * 72 + lc) = rb2;
    *(uint4*)(Bs + (lr + 96) * 72 + lc) = rb3;
    *(uint4*)(Bs + (lr + 128) * 72 + lc) = rb4;
    *(uint4*)(Bs + (lr + 160) * 72 + lc) = rb5;
    *(uint4*)(Bs + (lr + 192) * 72 + lc) = rb6;
    *(uint4*)(Bs + (lr + 224) * 72 + lc) = rb7;
    __syncthreads();
    if (k0 + 64 < K) {
      const int kk = k0 + 64;
      ra0 = GL_A(0); ra1 = GL_A(1); ra2 = GL_A(2); ra3 = GL_A(3);
      rb0 = GL_B(0); rb1 = GL_B(1); rb2 = GL_B(2); rb3 = GL_B(3);
      rb4 = GL_B(4); rb5 = GL_B(5); rb6 = GL_B(6); rb7 = GL_B(7);
    }
#pragma unroll
    for (int ks = 0; ks < 4; ++ks) {
      bf16x8 af[2], bf[4];
#pragma unroll
      for (int mi = 0; mi < 2; ++mi)
        af[mi] = *(const bf16x8*)(As + (wm * 64 + mi * 32 + (lane & 31)) * 72 + ks * 16 + (lane >> 5) * 8);
#pragma unroll
      for (int nj = 0; nj < 4; ++nj)
        bf[nj] = *(const bf16x8*)(Bs + (wn * 128 + nj * 32 + (lane & 31)) * 72 + ks * 16 + (lane >> 5) * 8);
#pragma unroll
      for (int mi = 0; mi < 2; ++mi)
#pragma unroll
        for (int nj = 0; nj < 4; ++nj) acc[nj >> 1][mi][nj & 1] = MFMA32(af[mi], bf[nj], acc[nj >> 1][mi][nj & 1]);
    }
  }
#undef GL_A
#undef GL_B
  hook();
  epi(tm * 128 + wm * 64, tn * 256 + wn * 128, acc[0]);
  epi(tm * 128 + wm * 64, tn * 256 + wn * 128 + 64, acc[1]);
}

struct EpiWin {
  const Params& p;
  int l;
  DI void operator()(int row0, int col0, f32x16 (&acc)[2][2]) const {
    const int lane = tidx() & 63, h = lane >> 5, c32 = lane & 31;
    u16* qkv = (u16*)(p.ws + O_QKV);
    u16* hyT = (u16*)(p.ws + O_HYT);
    u16* hg = (u16*)(p.ws + O_HG);
    u16* bcat = (u16*)(p.ws + O_BCAT);
    const float2* rope = (const float2*)(p.ws + O_ROPE);
#pragma unroll
    for (int mi = 0; mi < 2; ++mi) {
      const int rb = row0 + mi * 32;
#pragma unroll
      for (int ni = 0; ni < 2; ++ni) {
        const int cb = col0 + ni * 32, col = cb + c32;
        if (cb < 768) {
          const bool sample = rb >= TP;
#pragma unroll
          for (int i = 0; i < 16; ++i) {
            const int row = rb + crow(i, h);
            float v = acc[mi][ni][i];
            if (cb < 512) {
              if (sample) {
                const int pos = (row - TP) & 4095, idx = col & 31;
                const float2 cs = rope[pos * 16 + (idx >> 4) * 8 + (idx & 7)];
                const float pv = __shfl_xor(v, 8);
                v = ((idx >> 3) & 1) ? (v * cs.x + pv * cs.y) : (v * cs.x - pv * cs.y);
              } else if (cb >= 256) {
                const int b = row >> 8, t = row & 255;
                p.out[OUT_K + ((size_t)((b * 2 + l) * 256 + t)) * 256 + (col - 256)] = v;
              }
              if (cb < 256) v *= QSCALE;
            } else if (!sample) {
              const int b = row >> 8, t = row & 255;
              p.out[OUT_V + ((size_t)((b * 2 + l) * 256 + t)) * 256 + (col - 512)] = v;
            }
            qkv[(size_t)row * 768 + col] = f2bf(v);
          }
        } else if (cb < 1536) {
          const int c = col - 768;
#pragma unroll
          for (int g4 = 0; g4 < 4; ++g4) {
            uint2 pk;
            pk.x = pack2(acc[mi][ni][4 * g4], acc[mi][ni][4 * g4 + 1]);
            pk.y = pack2(acc[mi][ni][4 * g4 + 2], acc[mi][ni][4 * g4 + 3]);
            *(uint2*)(hyT + (size_t)c * TT + rb + 8 * g4 + 4 * h) = pk;
          }
        } else if (cb < 2816) {
#pragma unroll
          for (int i = 0; i < 16; ++i) {
            const int row = rb + crow(i, h);
            hg[(size_t)row * 1280 + (col - 1536)] = f2bf(acc[mi][ni][i]);
          }
        } else {
          const int cu = col - 2816, g = cu >> 4, hh = cu & 15;
#pragma unroll
          for (int i = 0; i < 16; ++i) {
            const int row = rb + crow(i, h);
            bcat[((size_t)(g * NCH32 + (row >> 5))) * 768 + (row & 31) * 16 + hh] = f2bf(acc[mi][ni][i]);
          }
        }
      }
    }
  }
};

struct EpiRes {
  const Params& p;
  const float* xp;
  const float* xs;
  const float* gate;
  DI void operator()(int row0, int col0, f32x16 (&acc)[2][2]) const {
    const int lane = tidx() & 63, h = lane >> 5, c32 = lane & 31;
#pragma unroll
    for (int mi = 0; mi < 2; ++mi)
#pragma unroll
      for (int ni = 0; ni < 2; ++ni) {
        const int col = col0 + ni * 32 + c32;
        const float g = gate[modvec(row0) * 6144 + col];
#pragma unroll
        for (int i = 0; i < 16; ++i) {
          const int row = row0 + mi * 32 + crow(i, h);
          const float xin = row < TP ? xp[(size_t)row * 1024 + col] : xs[(size_t)(row - TP) * 1024 + col];
          p.out[(size_t)row * 1024 + col] = ALPHA * xin + g * acc[mi][ni][i];
        }
      }
  }
};

struct EpiFfnIn {
  const Params& p;
  DI void operator()(int row0, int col0, f32x16 (&acc)[2][2]) const {
    const int lane = tidx() & 63, h = lane >> 5, c32 = lane & 31;
    u16* act = (u16*)(p.ws + O_ACT);
    const int j = (col0 >> 6) * 32 + c32;
#pragma unroll
    for (int mi = 0; mi < 2; ++mi)
#pragma unroll
      for (int i = 0; i < 16; ++i) {
        const int row = row0 + mi * 32 + crow(i, h);
        const float g = acc[mi][0][i], u = acc[mi][1][i];
        act[(size_t)row * 2816 + j] = f2bf(siluf_(g) * u);
      }
  }
};

struct EpiS5E {
  const Params& p;
  int g;
  DI void operator()(int row0, int col0, f32x16 (&acc)[2][2]) const {
    const int lane = tidx() & 63, h = lane >> 5, c32 = lane & 31;
    float* xloc = (float*)(p.ws + O_XLOC);
#pragma unroll
    for (int mi = 0; mi < 2; ++mi)
#pragma unroll
      for (int ni = 0; ni < 2; ++ni) {
        const int col = col0 + ni * 32 + c32;
#pragma unroll
        for (int i = 0; i < 16; ++i) {
          const int row = row0 + mi * 32 + crow(i, h);
          if (row < NCH32) xloc[((size_t)(g * NCH32 + row)) * 256 + col] = acc[mi][ni][i];
        }
      }
  }
};

struct EpiS5Y {
  const Params& p;
  int g;
  DI void operator()(int row0, int col0, f32x16 (&acc)[2][2]) const {
    const int lane = tidx() & 63, h = lane >> 5, c32 = lane & 31;
    u16* zs5 = (u16*)(p.ws + O_ZS5);
#pragma unroll
    for (int mi = 0; mi < 2; ++mi)
#pragma unroll
      for (int ni = 0; ni < 2; ++ni) {
        const int chunk = col0 + ni * 32 + c32;
#pragma unroll
        for (int i = 0; i < 16; ++i) {
          const int m = row0 + mi * 32 + crow(i, h);
          if (chunk < NCH32)
            zs5[((size_t)(chunk * 32 + (m >> 4))) * 256 + g * 16 + (m & 15)] = f2bf(gelu_tanh(acc[mi][ni][i]));
        }
      }
  }
};

struct EpiGlu {
  const Params& p;
  int l;
  DI void operator()(int row0, int col0, f32x16 (&acc)[2][2]) const {
    const int lane = tidx() & 63, h = lane >> 5, c32 = lane & 31;
    const u16* zs5 = (const u16*)(p.ws + O_ZS5);
    u16* mix = (u16*)(p.ws + O_HMIX);
#pragma unroll
    for (int mi = 0; mi < 2; ++mi)
#pragma unroll
      for (int ni = 0; ni < 2; ++ni) {
        const int col = col0 + ni * 32 + c32;
        const float bb = lnd(p.s5_glu_b)[l * 256 + col];
#pragma unroll
        for (int i = 0; i < 16; ++i) {
          const int row = row0 + mi * 32 + crow(i, h);
          const float z = bf2f(zs5[(size_t)row * 256 + col]);
          mix[(size_t)row * 1024 + 768 + col] = f2bf(z * sigmoidf_(acc[mi][ni][i] + bb));
        }
      }
  }
};

DI void convert_tile(const float* __restrict__ W, int K, int N, u16* __restrict__ Wt, int perm, int item, char* smem) {
  float(*tile)[65] = (float(*)[65])smem;
  const int tid = tidx();
  const int tilesN = N >> 6, kt = item / tilesN, nt = item % tilesN;
  __syncthreads();
#pragma unroll
  for (int q = 0; q < 4; ++q) {
    const int r = q * 16 + (tid >> 4), cq = (tid & 15) * 4;
    const float4 v = *(const float4*)(W + (size_t)(kt * 64 + r) * N + nt * 64 + cq);
    tile[r][cq] = v.x;
    tile[r][cq + 1] = v.y;
    tile[r][cq + 2] = v.z;
    tile[r][cq + 3] = v.w;
  }
  __syncthreads();
#pragma unroll
  for (int q = 0; q < 2; ++q) {
    const int idx = tid + q * 256, n = idx >> 3, kq = idx & 7;
    uint4 o;
    o.x = pack2(tile[kq * 8 + 0][n], tile[kq * 8 + 1][n]);
    o.y = pack2(tile[kq * 8 + 2][n], tile[kq * 8 + 3][n]);
    o.z = pack2(tile[kq * 8 + 4][n], tile[kq * 8 + 5][n]);
    o.w = pack2(tile[kq * 8 + 6][n], tile[kq * 8 + 7][n]);
    int nn = nt * 64 + n;
    if (perm) nn = nn < 2816 ? ((nn >> 5) * 64 + (nn & 31)) : ((((nn - 2816) >> 5) * 64) + 32 + ((nn - 2816) & 31));
    *(uint4*)(Wt + (size_t)nn * K + kt * 64 + kq * 8) = o;
  }
}

constexpr int CV_IN = 16 * 48, CV_OUT = 16 * 16, CV_FFI = 16 * 88, CV_FFO = 44 * 16, CV_GLU = 16;
constexpr int CV_TOTAL = CV_IN + CV_OUT + CV_FFI + CV_FFO + CV_GLU;
DI void convert_item(const Params& p, int l, int item, char* smem) {
  if (item < CV_IN) return convert_tile(lnd(p.w_in) + (size_t)l * 1024 * 3072, 1024, 3072, (u16*)(p.ws + O_WT_IN), 0, item, smem);
  item -= CV_IN;
  if (item < CV_OUT) return convert_tile(lnd(p.w_out) + (size_t)l * 1024 * 1024, 1024, 1024, (u16*)(p.ws + O_WT_OUT), 0, item, smem);
  item -= CV_OUT;
  if (item < CV_FFI) return convert_tile(lnd(p.w_ffi) + (size_t)l * 1024 * 5632, 1024, 5632, (u16*)(p.ws + O_WT_FFI), 1, item, smem);
  item -= CV_FFI;
  if (item < CV_FFO) return convert_tile(lnd(p.w_ffo) + (size_t)l * 2816 * 1024, 2816, 1024, (u16*)(p.ws + O_WT_FFO), 0, item, smem);
  item -= CV_FFO;
  convert_tile(lnd(p.s5_glu_w) + (size_t)l * 256 * 256, 256, 256, (u16*)(p.ws + O_WT_GLU), 0, item, smem);
}

DI void mod_item(const Params& p, int item, char* smem) {
  float* s = (float*)smem;
  float* red = s + 5 * 1024;
  const int tid = tidx(), lane = tid & 63, w = tid >> 6;
  const int l = item / 96, n = (item % 96) * 64 + lane;
  __syncthreads();
  for (int i = tid; i < 5120; i += 256) {
    const int v = i >> 10, k = i & 1023;
    const float x = v == 0 ? lnd(p.c_ctx)[k] : lnd(p.c)[(v - 1) * 1024 + k];
    s[i] = x / (1.f + expf(-x));
  }
  __syncthreads();
  float a0 = 0, a1 = 0, a2 = 0, a3 = 0, a4 = 0;
  const float* W = lnd(p.w_mod) + ((size_t)l * 1024 + w * 256) * 6144 + n;
#pragma unroll 16
  for (int k = 0; k < 256; ++k) {
    const float wv = W[(size_t)k * 6144];
    const int kk = w * 256 + k;
    a0 += s[kk] * wv;
    a1 += s[1024 + kk] * wv;
    a2 += s[2048 + kk] * wv;
    a3 += s[3072 + kk] * wv;
    a4 += s[4096 + kk] * wv;
  }
  red[(w * 5 + 0) * 64 + lane] = a0;
  red[(w * 5 + 1) * 64 + lane] = a1;
  red[(w * 5 + 2) * 64 + lane] = a2;
  red[(w * 5 + 3) * 64 + lane] = a3;
  red[(w * 5 + 4) * 64 + lane] = a4;
  __syncthreads();
  float* mod = (float*)(p.ws + O_MOD);
  for (int i = tid; i < 320; i += 256) {
    const int v = i >> 6, ln = i & 63, nn = (item % 96) * 64 + ln;
    float t = lnd(p.b_mod)[l * 6144 + nn];
    for (int ww = 0; ww < 4; ++ww) t += red[(ww * 5 + v) * 64 + ln];
    mod[(size_t)(l * 5 + v) * 6144 + nn] = t;
  }
}

DI void rope_item(const Params& p, int item) {
  const int idx = item * 256 + tidx();
  const int pos = idx >> 4, a = (idx >> 3) & 1, f = idx & 7;
  const float coord = a == 0 ? (float)(pos >> 6) : (float)(pos & 63);
  const float inv = powf(10000.f, -(float)(2 * f) / 16.f);
  const float ang = coord * inv;
  float2 cs;
  cs.x = cosf(ang);
  cs.y = sinf(ang);
  ((float2*)(p.ws + O_ROPE))[idx] = cs;
}

DI void lbv_item(const Params& p) {
  float* lbv = (float*)(p.ws + O_LBV);
  for (int i = tidx(); i < 512; i += 256) {
    const float e0 = lnd(p.hgrn_lb)[i], e1 = lnd(p.hgrn_lb)[512 + i];
    const float m = fmaxf(e0, e1);
    const float x0 = expf(e0 - m), x1 = expf(e1 - m);
    lbv[i] = 0.f;
    lbv[512 + i] = x1 / (x0 + x1);
  }
}

DI void hyf_item(const Params& p, int l, int item, char* smem) {
  const int tid = tidx();
  const bool sample = item < 256;
  const int L = sample ? 4096 : 256;
  const int l0 = (sample ? item : item - 256) * 16;
  float* z = (float*)smem;
  float* h1 = z + 16 * 17;
  float* h2 = h1 + 16 * 64;
  __syncthreads();
  for (int i = tid; i < 16 * 17; i += 256) {
    const int li = i / 17, k = i % 17;
    const float tl = (float)(l0 + li);
    float val;
    if (k == 0) val = tl / (float)(L - 1);
    else {
      const int b = (k - 1) & 7;
      const float band = 1e-4f + (float)b * ((7.f - 1e-4f) / 7.f);
      const float ang = (6.283185307179586f / (float)L) * tl * band;
      val = k <= 8 ? cosf(ang) : -sinf(ang);
    }
    z[i] = val;
  }
  __syncthreads();
  const float* w1 = lnd(p.hy_w1) + l * 17 * 64;
  const float* w2 = lnd(p.hy_w2) + l * 64 * 64;
  const float* w3 = lnd(p.hy_w3) + (size_t)l * 64 * 1024;
  for (int i = tid; i < 1024; i += 256) {
    const int li = i >> 6, j = i & 63;
    float a = lnd(p.hy_b1)[l * 64 + j];
#pragma unroll
    for (int k = 0; k < 17; ++k) a += z[li * 17 + k] * w1[k * 64 + j];
    h1[i] = sinf(lnd(p.hy_freq)[l * 64 + j] * a);
  }
  __syncthreads();
  for (int i = tid; i < 1024; i += 256) {
    const int li = i >> 6, j = i & 63;
    float a = lnd(p.hy_b2)[l * 64 + j];
#pragma unroll 16
    for (int k = 0; k < 64; ++k) a += h1[li * 64 + k] * w2[k * 64 + j];
    h2[i] = sinf(lnd(p.hy_freq)[l * 64 + j] * a);
  }
  __syncthreads();
  u16* dst = (u16*)(p.ws + O_HYF + (sample ? 0 : SZ_HYF_S));
  const float slow = logf(1e-2f) / 1.5f, quick = logf(1e-2f) / 0.3f;
#pragma unroll 1
  for (int cc = 0; cc < 4; ++cc) {
    const int col = tid + cc * 256;
    float acc[16];
#pragma unroll
    for (int li = 0; li < 16; ++li) acc[li] = 0.f;
#pragma unroll 8
    for (int k = 0; k < 64; ++k) {
      const float wv = w3[k * 1024 + col];
#pragma unroll
      for (int li = 0; li < 16; ++li) acc[li] += h2[li * 64 + k] * wv;
    }
    const int ch = col & 255;
    const float delta = fabsf(slow + (quick - slow) * ((float)ch / 255.f));
    unsigned pk[8];
#pragma unroll
    for (int li = 0; li < 16; li += 2) {
      const float t0 = (float)(l0 + li) / (float)(L - 1), t1 = (float)(l0 + li + 1) / (float)(L - 1);
      pk[li >> 1] = pack2(acc[li] * expf(-t0 * delta), acc[li + 1] * expf(-t1 * delta));
    }
    u16* d = dst + ((size_t)col) * L + l0;
    *(uint4*)(d) = make_uint4(pk[0], pk[1], pk[2], pk[3]);
    *(uint4*)(d + 8) = make_uint4(pk[4], pk[5], pk[6], pk[7]);
  }
}

DI void s5prep_item(const Params& p, int l, int item, char* smem) {
  const int tid = tidx();
  const int g = item >> 5, t = item & 31;
  float2* apow = (float2*)smem;
  float2* Bb = apow + 33 * 64;
  float2* Cc = Bb + 64 * 16;
  u16* acat = (u16*)(p.ws + O_ACAT) + (size_t)g * 512 * 768;
  u16* emat = (u16*)(p.ws + O_EMAT) + (size_t)g * 256 * 512;
  const int h = tid >> 4, hp = tid & 15;
#pragma unroll 1
  for (int dir = 0; dir < 2; ++dir) {
    const int bld = (l * 2 + dir) * 16 + g;
    const float dt = expf(lnd(p.s5_logdt)[bld]);
    __syncthreads();
    for (int i = tid; i < 33 * 64; i += 256) {
      const int j = i >> 6, pp = i & 63;
      const float re = lnd(p.s5_lre)[bld * 64 + pp], im = lnd(p.s5_lim)[bld * 64 + pp];
      const float mag = expf((float)j * re * dt), ang = (float)j * im * dt;
      apow[i] = make_float2(mag * cosf(ang), mag * sinf(ang));
    }
    for (int i = tid; i < 1024; i += 256) {
      const int pp = i >> 4, hh = i & 15;
      const float re = lnd(p.s5_lre)[bld * 64 + pp], im = lnd(p.s5_lim)[bld * 64 + pp];
      const float mag = expf(re * dt), ang = im * dt;
      const float nr = mag * cosf(ang) - 1.f, ni = mag * sinf(ang);
      const float den = 1.f / (re * re + im * im);
      const float cr = (nr * re + ni * im) * den, ci = (ni * re - nr * im) * den;
      const float br = lnd(p.s5_b)[((size_t)(bld * 64 + pp) * 16 + hh) * 2], bi = lnd(p.s5_b)[((size_t)(bld * 64 + pp) * 16 + hh) * 2 + 1];
      Bb[i] = make_float2(cr * br - ci * bi, cr * bi + ci * br);
    }
    for (int i = tid; i < 1024; i += 256) {
      const int hh = i >> 6, pp = i & 63;
      Cc[i] = make_float2(lnd(p.s5_c)[((size_t)(bld * 16 + hh) * 64 + pp) * 2], lnd(p.s5_c)[((size_t)(bld * 16 + hh) * 64 + pp) * 2 + 1]);
    }
    __syncthreads();
    {
      float kacc = 0.f;
      for (int pp = 0; pp < 64; ++pp) {
        const float2 cv = Cc[h * 64 + pp], bv = Bb[pp * 16 + hp], a = apow[t * 64 + pp];
        const float dr = cv.x * bv.x - cv.y * bv.y, di = cv.x * bv.y + cv.y * bv.x;
        kacc += dr * a.x - di * a.y;
      }
      ((float*)(p.ws + O_KTAB))[((size_t)((g * 2 + dir) * 32 + t)) * 256 + tid] = kacc;
    }
    for (int i = tid; i < 1024; i += 256) {
      const int hh = i >> 6, pp = i & 63;
      const int e = dir == 0 ? t + 1 : 32 - t;
      const float2 cv = Cc[i], a = apow[e * 64 + pp];
      const float wr = cv.x * a.x - cv.y * a.y, wi = cv.x * a.y + cv.y * a.x;
      *(unsigned*)(acat + (size_t)(t * 16 + hh) * 768 + 512 + dir * 128 + pp * 2) = pack2(wr, -wi);
    }
    for (int i = tid; i < 1024; i += 256) {
      const int pp = i >> 4, hh = i & 15;
      const int e = dir == 0 ? 31 - t : t;
      const float2 bv = Bb[i], a = apow[e * 64 + pp];
      const float wr = a.x * bv.x - a.y * bv.y, wi = a.x * bv.y + a.y * bv.x;
      emat[(size_t)(dir * 128 + pp * 2) * 512 + t * 16 + hh] = f2bf(wr);
      emat[(size_t)(dir * 128 + pp * 2 + 1) * 512 + t * 16 + hh] = f2bf(wi);
    }
    if (t == 0 && tid < 64) ((float2*)(p.ws + O_AT))[(dir * 16 + g) * 64 + tid] = apow[32 * 64 + tid];
  }
}

DI void s5expand_item(const Params& p, int l, int item) {
  const int tid = tidx();
  const int g = item >> 5, t = item & 31, h = tid >> 4, hp = tid & 15;
  u16* acat = (u16*)(p.ws + O_ACAT) + (size_t)g * 512 * 768;
  const float* kf = (const float*)(p.ws + O_KTAB) + (size_t)(g * 2 + 0) * 32 * 256 + tid;
  const float* kb = (const float*)(p.ws + O_KTAB) + (size_t)(g * 2 + 1) * 32 * 256 + tid;
  const float dsk = lnd(p.s5_d)[l * 256 + g * 16 + h];
#pragma unroll 8
  for (int r = 0; r < 32; ++r) {
    float v = 0.f;
    if (t >= r) v += kf[(t - r) * 256];
    if (r >= t) v += kb[(r - t) * 256];
    if (r == t && h == hp) v += dsk;
    acat[(size_t)(t * 16 + h) * 768 + r * 16 + hp] = f2bf(v);
  }
}

DI void ln_item(const Params& p, int item, const float* srcP, const float* srcS, const float* G, const float* B,
                const float* modl, int shi, int sci) {
  const int tid = tidx(), lane = tid & 63, w = tid >> 6;
  const int row0 = item * 8 + w * 2;
  const float* src = row0 < TP ? srcP + (size_t)row0 * 1024 : srcS + (size_t)(row0 - TP) * 1024;
  float4 v[2][4];
#pragma unroll
  for (int r = 0; r < 2; ++r)
#pragma unroll
    for (int i = 0; i < 4; ++i) v[r][i] = *(const float4*)(src + r * 1024 + lane * 4 + 256 * i);
  float mean[2], rstd[2];
#pragma unroll
  for (int r = 0; r < 2; ++r) {
    float s = 0.f;
#pragma unroll
    for (int i = 0; i < 4; ++i) s += v[r][i].x + v[r][i].y + v[r][i].z + v[r][i].w;
    mean[r] = wave_sum(s) * (1.f / 1024.f);
    float q = 0.f;
#pragma unroll
    for (int i = 0; i < 4; ++i) {
      v[r][i].x -= mean[r]; v[r][i].y -= mean[r]; v[r][i].z -= mean[r]; v[r][i].w -= mean[r];
      q += v[r][i].x * v[r][i].x + v[r][i].y * v[r][i].y + v[r][i].z * v[r][i].z + v[r][i].w * v[r][i].w;
    }
    rstd[r] = rsqrtf(wave_sum(q) * (1.f / 1024.f) + LN_EPS);
  }
  if (G) {
#pragma unroll
    for (int r = 0; r < 2; ++r) {
      float s2 = 0.f;
#pragma unroll
      for (int i = 0; i < 4; ++i) {
        const int col = lane * 4 + 256 * i;
        const float4 g = *(const float4*)(G + col), b = *(const float4*)(B + col);
        v[r][i].x = v[r][i].x * rstd[r] * g.x + b.x;
        v[r][i].y = v[r][i].y * rstd[r] * g.y + b.y;
        v[r][i].z = v[r][i].z * rstd[r] * g.z + b.z;
        v[r][i].w = v[r][i].w * rstd[r] * g.w + b.w;
        *(float4*)(p.out + (size_t)(row0 + r) * 1024 + col) = v[r][i];
        s2 += v[r][i].x + v[r][i].y + v[r][i].z + v[r][i].w;
      }
      mean[r] = s2;
    }
    if (!modl) return;
#pragma unroll
    for (int r = 0; r < 2; ++r) {
      const float m2 = wave_sum(mean[r]) * (1.f / 1024.f);
      float q = 0.f;
#pragma unroll
      for (int i = 0; i < 4; ++i) {
        v[r][i].x -= m2; v[r][i].y -= m2; v[r][i].z -= m2; v[r][i].w -= m2;
        q += v[r][i].x * v[r][i].x + v[r][i].y * v[r][i].y + v[r][i].z * v[r][i].z + v[r][i].w * v[r][i].w;
      }
      rstd[r] = rsqrtf(wave_sum(q) * (1.f / 1024.f) + LN_EPS);
    }
  }
  const float* mv = modl + modvec(row0) * 6144;
#pragma unroll
  for (int r = 0; r < 2; ++r) {
    u16* hb = (u16*)(p.ws + O_HMIX) + (size_t)(row0 + r) * 1024;
#pragma unroll
    for (int i = 0; i < 4; ++i) {
      const int col = lane * 4 + 256 * i;
      const float4 sc = *(const float4*)(mv + sci * 1024 + col), sh = *(const float4*)(mv + shi * 1024 + col);
      uint2 o;
      o.x = pack2(v[r][i].x * rstd[r] * (1.f + sc.x) + sh.x, v[r][i].y * rstd[r] * (1.f + sc.y) + sh.y);
      o.y = pack2(v[r][i].z * rstd[r] * (1.f + sc.z) + sh.z, v[r][i].w * rstd[r] * (1.f + sc.w) + sh.w);
      *(uint2*)(hb + col) = o;
    }
  }
}

DI void attn_item(const Params& p, int l, int item, char* smem) {
  const int tid = tidx(), lane = tid & 63, w = tid >> 6, h = lane >> 5, c32 = lane & 31;
  int b, head, qb, rowK0, Llat, ncache;
  if (item < 512) {
    b = item >> 7; head = (item >> 5) & 3; qb = item & 31;
    rowK0 = TP + b * 4096; Llat = 4096; ncache = 512;
  } else {
    const int it = item - 512;
    b = it >> 3; head = (it >> 1) & 3; qb = it & 1;
    rowK0 = b * 256; Llat = 256; ncache = 0;
  }
  const int ntiles = (Llat + ncache) >> 6;
  const u16* qkv = (const u16*)(p.ws + O_QKV);
  u16* Ks = (u16*)smem;
  u16* Vt = Ks + 64 * 72;
  float lam, oml;
  {
    const float* lp = lnd(p.diff_lambda) + l * 128;
    const float s1 = wave_sum(c32 == lane ? lp[c32] * lp[32 + c32] : 0.f);
    const float s2 = wave_sum(c32 == lane ? lp[64 + c32] * lp[96 + c32] : 0.f);
    const float lam_init = 0.8f - 0.6f * expf(-0.3f * (float)l);
    lam = expf(s1) - expf(s2) + lam_init;
    oml = 1.f - lam_init;
  }
  const int qrow = rowK0 + qb * 128 + w * 32 + c32;
  bf16x8 qf[2][2];
#pragma unroll
  for (int m = 0; m < 2; ++m)
#pragma unroll
    for (int ks = 0; ks < 2; ++ks)
      qf[m][ks] = *(const bf16x8*)(qkv + (size_t)qrow * 768 + head * 64 + m * 32 + ks * 16 + h * 8);

  uint4 kreg[2], vreg[2];
  const int vkp = c32, veg = w * 2 + h;
  auto load_tile = [&](int tile) {
    if (tile * 64 < Llat) {
#pragma unroll
      for (int q = 0; q < 2; ++q) {
        const int id = tid + 256 * q, key = id >> 3, part = id & 7;
        const size_t row = rowK0 + tile * 64 + key;
        kreg[q] = *(const uint4*)(qkv + row * 768 + 256 + head * 64 + part * 8);
        const size_t vrow = rowK0 + tile * 64 + 2 * vkp + q;
        vreg[q] = *(const uint4*)(qkv + vrow * 768 + 512 + head * 64 + veg * 8);
      }
    } else {
#pragma unroll
      for (int q = 0; q < 2; ++q) {
        const int id = tid + 256 * q, key = id >> 3, part = id & 7;
        const int t = tile * 64 - Llat + key;
        const size_t off = ((size_t)((b * 2 + l) * 512 + t) * 4 + head) * 64 + part * 8;
        const float4 k0 = *(const float4*)(lnd(p.cache_k) + off), k1 = *(const float4*)(lnd(p.cache_k) + off + 4);
        kreg[q] = make_uint4(pack2(k0.x, k0.y), pack2(k0.z, k0.w), pack2(k1.x, k1.y), pack2(k1.z, k1.w));
        const int tv = tile * 64 - Llat + 2 * vkp + q;
        const size_t voff = ((size_t)((b * 2 + l) * 512 + tv) * 4 + head) * 64 + veg * 8;
        const float4 v0 = *(const float4*)(lnd(p.cache_v) + voff), v1 = *(const float4*)(lnd(p.cache_v) + voff + 4);
        vreg[q] = make_uint4(pack2(v0.x, v0.y), pack2(v0.z, v0.w), pack2(v1.x, v1.y), pack2(v1.z, v1.w));
      }
    }
  };
  f32x16 O[2][2];
#pragma unroll
  for (int m = 0; m < 2; ++m)
#pragma unroll
    for (int e = 0; e < 2; ++e)
#pragma unroll
      for (int i = 0; i < 16; ++i) O[m][e][i] = 0.f;
  float mold[2] = {-1e30f, -1e30f}, lsum[2] = {0.f, 0.f};
  load_tile(0);
  for (int tile = 0; tile < ntiles; ++tile) {
    __syncthreads();
#pragma unroll
    for (int q = 0; q < 2; ++q) {
      const int id = tid + 256 * q, key = id >> 3, part = id & 7;
      *(uint4*)(Ks + key * 72 + part * 8) = kreg[q];
    }
    {
      const unsigned va[4] = {vreg[0].x, vreg[0].y, vreg[0].z, vreg[0].w};
      const unsigned vb[4] = {vreg[1].x, vreg[1].y, vreg[1].z, vreg[1].w};
      unsigned* Vd = (unsigned*)Vt;
#pragma unroll
      for (int j = 0; j < 4; ++j) {
        Vd[(veg * 8 + 2 * j) * 36 + vkp] = (va[j] & 0xffffu) | (vb[j] << 16);
        Vd[(veg * 8 + 2 * j + 1) * 36 + vkp] = (va[j] >> 16) | (vb[j] & 0xffff0000u);
      }
    }
    __syncthreads();
    if (tile + 1 < ntiles) load_tile(tile + 1);
#pragma unroll
    for (int m = 0; m < 2; ++m) {
      uint4 pf[2][2];
      {
        f32x16 s[2];
#pragma unroll
        for (int kb = 0; kb < 2; ++kb) {
#pragma unroll
          for (int i = 0; i < 16; ++i) s[kb][i] = 0.f;
#pragma unroll
          for (int ks = 0; ks < 2; ++ks) {
            const bf16x8 a = *(const bf16x8*)(Ks + (kb * 32 + c32) * 72 + m * 32 + ks * 16 + h * 8);
            s[kb] = MFMA32(a, qf[m][ks], s[kb]);
          }
        }
        float mx = s[0][0];
#pragma unroll
        for (int i = 0; i < 16; ++i) mx = fmaxf(mx, fmaxf(s[0][i], s[1][i]));
        mx = fmaxf(mx, __shfl_xor(mx, 32));
        const float mnew = fmaxf(mold[m], mx);
        const float alpha = __builtin_amdgcn_exp2f(mold[m] - mnew);
        mold[m] = mnew;
        float rs = 0.f;
#pragma unroll
        for (int kb = 0; kb < 2; ++kb) {
#pragma unroll
          for (int i = 0; i < 16; ++i) {
            const float pv = __builtin_amdgcn_exp2f(s[kb][i] - mnew);
            s[kb][i] = pv;
            rs += pv;
          }
#pragma unroll
          for (int sp = 0; sp < 2; ++sp)
            pf[kb][sp] = make_uint4(pack2(s[kb][8 * sp], s[kb][8 * sp + 1]), pack2(s[kb][8 * sp + 2], s[kb][8 * sp + 3]),
                                    pack2(s[kb][8 * sp + 4], s[kb][8 * sp + 5]), pack2(s[kb][8 * sp + 6], s[kb][8 * sp + 7]));
        }
        lsum[m] = lsum[m] * alpha + rs;
        if (__builtin_amdgcn_ballot_w64(alpha < 1.f) != 0) {
#pragma unroll
          for (int e = 0; e < 2; ++e)
#pragma unroll
            for (int i = 0; i < 16; ++i) O[m][e][i] *= alpha;
        }
      }
#pragma unroll
      for (int kb = 0; kb < 2; ++kb)
#pragma unroll
        for (int sp = 0; sp < 2; ++sp) {
          const bf16x8 pfr = __builtin_bit_cast(bf16x8, pf[kb][sp]);
#pragma unroll
          for (int e = 0; e < 2; ++e) {
            const u16* vp = Vt + (e * 32 + c32) * 72 + kb * 32 + sp * 16 + 4 * h;
            const uint2 lo = *(const uint2*)vp, hi = *(const uint2*)(vp + 8);
            const uint4 t4 = make_uint4(lo.x, lo.y, hi.x, hi.y);
            O[m][e] = MFMA32(__builtin_bit_cast(bf16x8, t4), pfr, O[m][e]);
          }
        }
    }
  }
  const float l1 = lsum[0] + __shfl_xor(lsum[0], 32), l2 = lsum[1] + __shfl_xor(lsum[1], 32);
  const float inv1 = 1.f / l1, inv2 = lam / l2;
  float ss = 0.f;
#pragma unroll
  for (int e = 0; e < 2; ++e)
#pragma unroll
    for (int i = 0; i < 16; ++i) {
      const float o = O[0][e][i] * inv1 - O[1][e][i] * inv2;
      O[0][e][i] = o;
      ss += o * o;
    }
  ss += __shfl_xor(ss, 32);
  const float r = rsqrtf(ss * (1.f / 64.f) + LN_EPS) * oml;
  u16* mix = (u16*)(p.ws + O_HMIX);
  const float* sg = lnd(p.diff_subln_g) + l * 64;
#pragma unroll
  for (int e = 0; e < 2; ++e)
#pragma unroll
    for (int g4 = 0; g4 < 4; ++g4) {
      const int e0 = e * 32 + 8 * g4 + 4 * h;
      uint2 o;
      o.x = pack2(O[0][e][4 * g4] * r * sg[e0], O[0][e][4 * g4 + 1] * r * sg[e0 + 1]);
      o.y = pack2(O[0][e][4 * g4 + 2] * r * sg[e0 + 2], O[0][e][4 * g4 + 3] * r * sg[e0 + 3]);
      *(uint2*)(mix + (size_t)qrow * 1024 + head * 64 + e0) = o;
    }
}

DI void shortconv4(const u16* seq, int t0, int L, float w0, float w1, float w2, float sb, float (&o)[4]) {
  const uint2 c = *(const uint2*)(seq + t0);
  const float x0 = bf2f((u16)(c.x & 0xffff)), x1 = bf2f((u16)(c.x >> 16)), x2 = bf2f((u16)(c.y & 0xffff)), x3 = bf2f((u16)(c.y >> 16));
  const float xm = t0 > 0 ? bf2f(seq[t0 - 1]) : 0.f;
  const float xp = t0 + 4 < L ? bf2f(seq[t0 + 4]) : 0.f;
  o[0] = w0 * xm + w1 * x0 + w2 * x1 + sb;
  o[1] = w0 * x0 + w1 * x1 + w2 * x2 + sb;
  o[2] = w0 * x1 + w1 * x2 + w2 * x3 + sb;
  o[3] = w0 * x2 + w1 * x3 + w2 * xp + sb;
}

template <bool SAMPLE>
DI void hyena_item(const Params& p, int l, int c, char* smem) {
  constexpr int L = SAMPLE ? 4096 : 256, NB = SAMPLE ? 4 : 16, LGNB = SAMPLE ? 2 : 4;
  constexpr int NIT = 32 / NB, PADB = NIT - 1, NI = L / 32;
  constexpr int LP = L + 2 * PADB * 32 + 80;
  constexpr int NTW = SAMPLE ? 4 : 1;
  constexpr int RL = 2 * L + 16;
  constexpr int ROW0 = SAMPLE ? TP : 0;
  const int tid = tidx(), lane = tid & 63, w = tid >> 6, h = lane >> 5, c32 = lane & 31;
  u16* U = (u16*)smem;
  u16* R = U + NB * LP;
  float* red = (float*)(R + RL);
  const u16* hyT = (const u16*)(p.ws + O_HYT);
  const u16* hyf = (const u16*)(p.ws + O_HYF + (SAMPLE ? 0 : SZ_HYF_S));
  const float* sw = lnd(p.hy_short_w) + (size_t)l * 3 * 768;
  const float* sbp = lnd(p.hy_short_b) + l * 768;
  __syncthreads();
  for (int i = tid; i < NB * PADB * 32 * 2; i += 256) {
    const int bb = i / (PADB * 64), r = i % (PADB * 64);
    const int off = r < PADB * 32 ? r : (PADB * 32 + L + (r - PADB * 32));
    U[bb * LP + off] = 0;
  }
  {
    const float w0 = sw[c], w1 = sw[768 + c], w2 = sw[1536 + c], sb = sbp[c];
    for (int gi = tid; gi < NB * L / 4; gi += 256) {
      const int bb = gi / (L / 4), t0 = (gi % (L / 4)) * 4;
      float o[4];
      shortconv4(hyT + (size_t)c * TT + ROW0 + bb * L, t0, L, w0, w1, w2, sb, o);
      uint2 pk;
      pk.x = pack2(o[0], o[1]);
      pk.y = pack2(o[2], o[3]);
      *(uint2*)(U + bb * LP + PADB * 32 + t0) = pk;
    }
  }
  const int b_n = c32 & (NB - 1), il = c32 >> LGNB;
  f32x16 acc[NTW];
#pragma unroll 1
  for (int o = 0; o < 2; ++o) {
    const u16* F0 = hyf + ((size_t)((o * 2 + 0) * 256 + c)) * L;
    const u16* F1 = hyf + ((size_t)((o * 2 + 1) * 256 + c)) * L;
    float ps = 0.f;
#pragma unroll 4
    for (int i = tid; i < L; i += 256) {
      const u16 a0 = F0[i], a1 = F1[i];
      ps += fabsf(bf2f(a0)) + (i >= 1 ? fabsf(bf2f(a1)) : 0.f);
    }
    ps = wave_sum(ps);
    if (lane == 0) red[w] = ps;
    __syncthreads();
    const float inorm = 1.f / (red[0] + red[1] + red[2] + red[3]);
    for (int yb = tid; yb < RL; yb += 1024) {
      u16 raw[4];
#pragma unroll
      for (int u = 0; u < 4; ++u) {
        const int lag = L - (yb + u * 256), al = lag < 0 ? -lag : lag;
        const u16* src = lag >= 0 ? F0 : F1;
        raw[u] = src[al < L ? al : L - 1];
      }
#pragma unroll
      for (int u = 0; u < 4; ++u) {
        const int y = yb + u * 256, lag = L - y, al = lag < 0 ? -lag : lag;
        if (y < RL) R[y] = al < L ? f2bf(bf2f(raw[u]) * inorm) : (u16)0;
      }
    }
    __syncthreads();
    const int i0w = (w * NTW) * NIT;
    const int dlo = i0w - (NI - 1), dhi = i0w + (NTW - 1) * NIT + NIT - 1;
    const unsigned* Rdw = (const unsigned*)R;
#pragma unroll 1
    for (int rep_ = 0; rep_ < PQ_CONV; ++rep_) {
#pragma unroll
    for (int k = 0; k < NTW; ++k)
#pragma unroll
      for (int i = 0; i < 16; ++i) acc[k][i] = 0.f;
#pragma unroll 1
    for (int d = dlo; d <= dhi; ++d) {
#pragma unroll
      for (int kk = 0; kk < 2; ++kk) {
        const int k0 = kk * 16 + h * 8;
        const int y0 = L - (32 * d + c32 - k0);
        const int q = y0 >> 1;
        const unsigned sh = (y0 & 1) * 16;
        const unsigned d0 = Rdw[q], d1 = Rdw[q + 1], d2 = Rdw[q + 2], d3 = Rdw[q + 3], d4 = Rdw[q + 4];
        const uint4 a4 = make_uint4(__builtin_amdgcn_alignbit(d1, d0, sh), __builtin_amdgcn_alignbit(d2, d1, sh),
                                    __builtin_amdgcn_alignbit(d3, d2, sh), __builtin_amdgcn_alignbit(d4, d3, sh));
        const bf16x8 af = __builtin_bit_cast(bf16x8, a4);
#pragma unroll
        for (int k = 0; k < NTW; ++k) {
          int j = i0w + k * NIT + il - d;
          j = j < -PADB ? -PADB : (j > NI - 1 + PADB ? NI - 1 + PADB : j);
          const bf16x8 bfr = *(const bf16x8*)(U + b_n * LP + (PADB + j) * 32 + k0);
          acc[k] = MFMA32(af, bfr, acc[k]);
        }
      }
    }
    }
    const int chx = 256 * (o + 1) + c;
    const float w0 = sw[chx], w1 = sw[768 + chx], w2 = sw[1536 + chx], sb = sbp[chx];
    const float bias = lnd(p.hy_bias)[(l * 2 + o) * 256 + c];
    const u16* xseq = hyT + (size_t)chx * TT + ROW0 + b_n * L;
    if (o == 0) __syncthreads();
#pragma unroll
    for (int k = 0; k < NTW; ++k) {
      const int ib = i0w + k * NIT + il;
#pragma unroll
      for (int g4 = 0; g4 < 4; ++g4) {
        __builtin_amdgcn_sched_barrier(0);
        const int t0 = ib * 32 + 8 * g4 + 4 * h;
        float xg[4];
        shortconv4(xseq, t0, L, w0, w1, w2, sb, xg);
        u16* up = U + b_n * LP + PADB * 32 + t0;
        const uint2 uu = *(const uint2*)up;
        const float u0 = bf2f((u16)(uu.x & 0xffff)), u1 = bf2f((u16)(uu.x >> 16)), u2 = bf2f((u16)(uu.y & 0xffff)), u3 = bf2f((u16)(uu.y >> 16));
        const float y0 = xg[0] * (acc[k][4 * g4] + u0 * bias), y1 = xg[1] * (acc[k][4 * g4 + 1] + u1 * bias);
        const float y2 = xg[2] * (acc[k][4 * g4 + 2] + u2 * bias), y3 = xg[3] * (acc[k][4 * g4 + 3] + u3 * bias);
        if (o == 0) {
          uint2 pk;
          pk.x = pack2(y0, y1);
          pk.y = pack2(y2, y3);
          *(uint2*)up = pk;
        } else {
          u16* mix = (u16*)(p.ws + O_HMIX);
          const size_t rowb = (size_t)(ROW0 + b_n * L + t0);
          mix[(rowb + 0) * 1024 + 256 + c] = f2bf(y0);
          mix[(rowb + 1) * 1024 + 256 + c] = f2bf(y1);
          mix[(rowb + 2) * 1024 + 256 + c] = f2bf(y2);
          mix[(rowb + 3) * 1024 + 256 + c] = f2bf(y3);
        }
      }
    }
    __syncthreads();
  }
}

template <int MODE>
DI void hgrn_item(const Params& p, int l, int item, char* smem) {
  const int tid = tidx(), lane = tid & 63, w = tid >> 6;
  int seq, head, dir, row0, sidj = 0;
  if (MODE == 0) { seq = item >> 3; head = (item >> 1) & 3; dir = item & 1; row0 = seq * 256; }
  else {
    const int j = item & 15, sid = item >> 4;
    seq = sid >> 3; head = (sid >> 1) & 3; dir = sid & 1;
    row0 = TP + seq * 4096 + (dir ? 15 - j : j) * 256;
    sidj = item;
  }
  constexpr int NC = 4;
  constexpr bool FULL = MODE != 1;
  constexpr int LD = 72;
  u16* Qm = (u16*)smem;
  u16* Km = Qm + 64 * LD;
  u16* Qb = Km + 64 * LD;
  u16* Klt = Qb + 64 * LD;
  u16* Vt = Klt + 64 * LD;
  u16* St = Vt + 64 * LD;
  float* ebl = (float*)(St + 64 * LD);
  float* tot = ebl + 64;
  float* lfs = (float*)smem;
  u16* Att = Qm;
  const u16* hg = (const u16*)(p.ws + O_HG);
  u16* hgo = (u16*)(p.ws + O_HGO) + (size_t)dir * TT * 256;
  const float* lbv = (const float*)(p.ws + O_LBV) + (l * 2 + dir) * 256 + head * 64;
  f32x4 st[4];
  const int er = 16 * w + (lane >> 4) * 4, dc = lane & 15;
#pragma unroll
  for (int dt = 0; dt < 4; ++dt)
#pragma unroll
    for (int r = 0; r < 4; ++r) {
      float v = 0.f;
      if (MODE == 2) v = ((const float*)(p.ws + O_SLOC))[(size_t)sidj * 4096 + (dt * 16 + dc) * 64 + er + r];
      st[dt][r] = v;
    }
  __syncthreads();
  float* lsumd = tot + 256;
  if (MODE == 1 && tid < 64) lsumd[tid] = 0.f;
#pragma unroll
  for (int dt = 0; dt < 4; ++dt)
#pragma unroll
    for (int r = 0; r < 4; ++r) St[(er + r) * LD + dt * 16 + dc] = f2bf(st[dt][r]);
  const int tau = tid >> 2, dseg = (tid & 3) * 16;
  float lbr[16];
#pragma unroll
  for (int j = 0; j < 16; ++j) lbr[j] = lbv[dseg + j];
  uint4 gq[2], gv[2], gz[2];
  auto gload = [&](int ci) {
    const int cidx = dir == 0 ? ci : NC - 1 - ci;
    const int t = cidx * 64 + (dir == 0 ? tau : 63 - tau);
    const u16* base = hg + (size_t)(row0 + t) * 1280 + head * 64 + dseg;
    gq[0] = *(const uint4*)(base); gq[1] = *(const uint4*)(base + 8);
    gv[0] = *(const uint4*)(base + 256); gv[1] = *(const uint4*)(base + 256 + 8);
    const int zo = dir == 0 ? 512 : 768;
    gz[0] = *(const uint4*)(base + zo); gz[1] = *(const uint4*)(base + zo + 8);
  };
  gload(0);
#pragma unroll 1
  for (int ci = 0; ci < NC; ++ci) {
    const int cidx = dir == 0 ? ci : NC - 1 - ci;
    float qv[16], kv[16], lf[16];
    {
      const unsigned qq[8] = {gq[0].x, gq[0].y, gq[0].z, gq[0].w, gq[1].x, gq[1].y, gq[1].z, gq[1].w};
      const unsigned zz[8] = {gz[0].x, gz[0].y, gz[0].z, gz[0].w, gz[1].x, gz[1].y, gz[1].z, gz[1].w};
      const unsigned vv[8] = {gv[0].x, gv[0].y, gv[0].z, gv[0].w, gv[1].x, gv[1].y, gv[1].z, gv[1].w};
#pragma unroll
      for (int j = 0; j < 16; ++j) {
        const float qr = bf2f((u16)((qq[j >> 1] >> ((j & 1) * 16)) & 0xffff));
        const float zr = bf2f((u16)((zz[j >> 1] >> ((j & 1) * 16)) & 0xffff));
        qv[j] = siluf_(qr);
        const float sg = frcp_(1.f + __expf(-zr));
        const float f = lbr[j] + (1.f - lbr[j]) * sg;
        kv[j] = 1.f - f;
        lf[j] = __logf(f);
        Vt[(dseg + j) * LD + tau] = (u16)((vv[j >> 1] >> ((j & 1) * 16)) & 0xffff);
        lfs[tau * 64 + dseg + j] = lf[j];
      }
    }
    __syncthreads();
    if (ci + 1 < NC) gload(ci + 1);
    {
      const int d = tid & 63, part = tid >> 6;
      float run[16];
      float a = 0.f;
#pragma unroll
      for (int j = 0; j < 16; ++j) {
        a += lfs[(part * 16 + j) * 64 + d];
        run[j] = a;
      }
      tot[part * 64 + d] = a;
      __syncthreads();
      float off = 0.f;
      for (int pp = 0; pp < part; ++pp) off += tot[pp * 64 + d];
#pragma unroll
      for (int j = 0; j < 16; ++j) lfs[(part * 16 + j) * 64 + d] = run[j] + off;
    }
    __syncthreads();
    float bb[16], bm[16], bl[16];
#pragma unroll
    for (int j = 0; j < 16; ++j) {
      bb[j] = lfs[tau * 64 + dseg + j];
      bm[j] = lfs[31 * 64 + dseg + j];
      bl[j] = lfs[63 * 64 + dseg + j];
    }
    __syncthreads();
#pragma unroll
    for (int j = 0; j < 16; j += 2) {
      if (FULL) {
        *(unsigned*)(Qm + tau * LD + dseg + j) = pack2(qv[j] * __expf(bb[j] - bm[j]), qv[j + 1] * __expf(bb[j + 1] - bm[j + 1]));
        *(unsigned*)(Km + tau * LD + dseg + j) = pack2(kv[j] * __expf(bm[j] - bb[j]), kv[j + 1] * __expf(bm[j + 1] - bb[j + 1]));
        *(unsigned*)(Qb + tau * LD + dseg + j) = pack2(qv[j] * __expf(bb[j]), qv[j + 1] * __expf(bb[j + 1]));
      }
      Klt[(dseg + j) * LD + tau] = f2bf(kv[j] * __expf(bl[j] - bb[j]));
      Klt[(dseg + j + 1) * LD + tau] = f2bf(kv[j + 1] * __expf(bl[j + 1] - bb[j + 1]));
    }
    if (tau == 63) {
#pragma unroll
      for (int j = 0; j < 16; ++j) {
        ebl[dseg + j] = __expf(bl[j]);
        if (MODE == 1) lsumd[dseg + j] += bl[j];
      }
    }
    __syncthreads();
    f32x4 at[4];
    if (FULL) {
      const int r16 = lane & 15, kq = (lane >> 4) * 8;
#pragma unroll
      for (int ct = 0; ct < 4; ++ct) {
        at[ct] = (f32x4){0.f, 0.f, 0.f, 0.f};
#pragma unroll
        for (int ks = 0; ks < 2; ++ks) {
          const bf16x8 a = *(const bf16x8*)(Qm + (16 * w + r16) * LD + ks * 32 + kq);
          const bf16x8 b = *(const bf16x8*)(Km + (16 * ct + r16) * LD + ks * 32 + kq);
          at[ct] = MFMA16(a, b, at[ct]);
        }
      }
    }
    if (FULL) {
      __syncthreads();
#pragma unroll
      for (int ct = 0; ct < 4; ++ct)
#pragma unroll
        for (int r = 0; r < 4; ++r) {
          const int trow = 16 * w + (lane >> 4) * 4 + r, scol = 16 * ct + (lane & 15);
          Att[trow * LD + scol] = scol <= trow ? f2bf(at[ct][r]) : (u16)0;
        }
      __syncthreads();
    }
    {
      const int r16 = lane & 15, kq = (lane >> 4) * 8;
#pragma unroll
      for (int ct = 0; ct < (FULL ? 4 : 0); ++ct) {
        f32x4 o = (f32x4){0.f, 0.f, 0.f, 0.f};
#pragma unroll
        for (int ks = 0; ks < 2; ++ks) {
          const bf16x8 a = *(const bf16x8*)(Att + (16 * w + r16) * LD + ks * 32 + kq);
          const bf16x8 b = *(const bf16x8*)(Vt + (16 * ct + r16) * LD + ks * 32 + kq);
          o = MFMA16(a, b, o);
        }
#pragma unroll
        for (int ks = 0; ks < 2; ++ks) {
          const bf16x8 a = *(const bf16x8*)(Qb + (16 * w + r16) * LD + ks * 32 + kq);
          const bf16x8 b = *(const bf16x8*)(St + (16 * ct + r16) * LD + ks * 32 + kq);
          o = MFMA16(a, b, o);
        }
#pragma unroll
        for (int r = 0; r < 4; ++r) {
          const int tl = 16 * w + (lane >> 4) * 4 + r;
          const int t = cidx * 64 + (dir == 0 ? tl : 63 - tl);
          hgo[(size_t)(row0 + t) * 256 + head * 64 + 16 * ct + (lane & 15)] = f2bf(o[r]);
        }
      }
#pragma unroll
      for (int dt = 0; dt < 4; ++dt) {
        const float sc = ebl[dt * 16 + (lane & 15)];
        f32x4 a4 = st[dt] * sc;
#pragma unroll
        for (int ks = 0; ks < 2; ++ks) {
          const bf16x8 a = *(const bf16x8*)(Vt + (16 * w + r16) * LD + ks * 32 + kq);
          const bf16x8 b = *(const bf16x8*)(Klt + (16 * dt + r16) * LD + ks * 32 + kq);
          a4 = MFMA16(a, b, a4);
        }
        st[dt] = a4;
      }
    }
    __syncthreads();
#pragma unroll
    for (int dt = 0; dt < 4; ++dt)
#pragma unroll
      for (int r = 0; r < 4; ++r) St[(er + r) * LD + dt * 16 + dc] = f2bf(st[dt][r]);
  }
  if (MODE == 0) {
#pragma unroll
    for (int dt = 0; dt < 4; ++dt)
#pragma unroll
      for (int r = 0; r < 4; ++r)
        p.out[OUT_HG + ((size_t)(((seq * 2 + l) * 2 + dir) * 4 + head) * 64 + (dt * 16 + dc)) * 64 + er + r] = st[dt][r];
  }
  if (MODE == 1) {
    float* sloc = (float*)(p.ws + O_SLOC) + (size_t)sidj * 4096;
#pragma unroll
    for (int dt = 0; dt < 4; ++dt)
#pragma unroll
      for (int r = 0; r < 4; ++r) sloc[(dt * 16 + dc) * 64 + er + r] = st[dt][r];
    if (tid < 64) ((float*)(p.ws + O_SDEC))[sidj * 64 + tid] = __expf(lsumd[tid]);
  }
}

DI void hgrn_scan_item(const Params& p, int l, int item) {
  const int idx = item * 256 + tidx();
  const int e = idx & 63, d = (idx >> 6) & 63, sid = idx >> 12;
  const int seq = sid >> 3, head = (sid >> 1) & 3, dir = sid & 1;
  float* sloc = (float*)(p.ws + O_SLOC) + (size_t)sid * 16 * 4096 + d * 64 + e;
  const float* sdec = (const float*)(p.ws + O_SDEC) + sid * 16 * 64 + d;
  float S = lnd(p.state_hgrn)[((size_t)(((seq * 2 + l) * 2 + dir) * 4 + head) * 64 + d) * 64 + e];
  float loc[16], dec[16];
#pragma unroll
  for (int j = 0; j < 16; ++j) {
    loc[j] = sloc[(size_t)j * 4096];
    dec[j] = sdec[j * 64];
  }
#pragma unroll
  for (int j = 0; j < 16; ++j) {
    sloc[(size_t)j * 4096] = S;
    S = dec[j] * S + loc[j];
  }
}

DI void hgrn_fin_item(const Params& p, int l, int item) {
  const int tid = tidx(), lane = tid & 63, w = tid >> 6;
  const int row = item * 4 + w;
  const u16* hgo = (const u16*)(p.ws + O_HGO);
  const u16* hg = (const u16*)(p.ws + O_HG);
  u16* mix = (u16*)(p.ws + O_HMIX);
  const int c0 = lane * 4;
  const uint2 a = *(const uint2*)(hgo + (size_t)row * 256 + c0), b = *(const uint2*)(hgo + ((size_t)TT + row) * 256 + c0);
  const uint2 gg = *(const uint2*)(hg + (size_t)row * 1280 + 1024 + c0);
  float o[4];
  o[0] = bf2f((u16)(a.x & 0xffff)) + bf2f((u16)(b.x & 0xffff));
  o[1] = bf2f((u16)(a.x >> 16)) + bf2f((u16)(b.x >> 16));
  o[2] = bf2f((u16)(a.y & 0xffff)) + bf2f((u16)(b.y & 0xffff));
  o[3] = bf2f((u16)(a.y >> 16)) + bf2f((u16)(b.y >> 16));
  float ss = o[0] * o[0] + o[1] * o[1] + o[2] * o[2] + o[3] * o[3];
#pragma unroll
  for (int m = 8; m >= 1; m >>= 1) ss += __shfl_xor(ss, m);
  const float r = rsqrtf(ss * (1.f / 64.f) + LN_EPS);
  const float* ng = lnd(p.hgrn_norm_g) + l * 64 + (c0 & 63);
  const float g0 = siluf_(bf2f((u16)(gg.x & 0xffff))), g1 = siluf_(bf2f((u16)(gg.x >> 16)));
  const float g2 = siluf_(bf2f((u16)(gg.y & 0xffff))), g3 = siluf_(bf2f((u16)(gg.y >> 16)));
  uint2 pk;
  pk.x = pack2(o[0] * r * ng[0] * g0, o[1] * r * ng[1] * g1);
  pk.y = pack2(o[2] * r * ng[2] * g2, o[3] * r * ng[3] * g3);
  *(uint2*)(mix + (size_t)row * 1024 + 512 + c0) = pk;
}

DI void s5scan_item(const Params& p, int l, int item) {
  const int gid = item * 256 + tidx();
  const int pp = gid & 63, g = (gid >> 6) & 15, dir = (gid >> 10) & 1, seq = gid >> 11;
  const bool sample = seq >= 16;
  const int nch = sample ? 128 : 8;
  const int ch0 = sample ? 128 + (seq - 16) * 128 : seq * 8;
  const float2 aT = ((const float2*)(p.ws + O_AT))[(dir * 16 + g) * 64 + pp];
  const float* xloc = (const float*)(p.ws + O_XLOC);
  u16* bcat = (u16*)(p.ws + O_BCAT);
  float xr = 0.f, xi = 0.f;
  if (sample) {
    const float* s0 = lnd(p.state_s5) + ((size_t)((((seq - 16) * 2 + l) * 2 + dir) * 16 + g) * 64 + pp) * 2;
    xr = s0[0];
    xi = s0[1];
  }
#pragma unroll 1
  for (int i0 = 0; i0 < nch; i0 += 8) {
    float2 xl[8];
#pragma unroll
    for (int j = 0; j < 8; ++j) {
      const int i = i0 + j, ch = dir == 0 ? ch0 + i : ch0 + nch - 1 - i;
      xl[j] = *(const float2*)(xloc + ((size_t)(g * NCH32 + ch)) * 256 + dir * 128 + pp * 2);
    }
#pragma unroll
    for (int j = 0; j < 8; ++j) {
      const int i = i0 + j, ch = dir == 0 ? ch0 + i : ch0 + nch - 1 - i;
      *(unsigned*)(bcat + ((size_t)(g * NCH32 + ch)) * 768 + 512 + dir * 128 + pp * 2) = pack2(xr, xi);
      const float nr = aT.x * xr - aT.y * xi + xl[j].x, ni = aT.x * xi + aT.y * xr + xl[j].y;
      xr = nr;
      xi = ni;
    }
  }
  if (!sample) {
    float* o = p.out + OUT_S5 + ((size_t)(((seq * 2 + l) * 2 + dir) * 16 + g) * 64 + pp) * 2;
    o[0] = xr;
    o[1] = xi;
  }
}

#define XB_TMO 128
#define XB_XCNT(j) (256 + 64 * (j))
#define XB_XSUB(j) (1280 + 64 * (j))
#define XB_XGEN(j) (2304 + 64 * (j))
#define XB_TOP 3328
#define XB_TOPGEN 3392
#define XCD_BAR_WORDS 3456
#define XB_SPIN_CAP (1u << 22)
#define LAS __attribute__((address_space(3)))
DI unsigned xb_ld(unsigned* p) { return __hip_atomic_load(p, __ATOMIC_RELAXED, __HIP_MEMORY_SCOPE_AGENT); }
DI unsigned xb_add(unsigned* p, unsigned v) { return __hip_atomic_fetch_add(p, v, __ATOMIC_RELAXED, __HIP_MEMORY_SCOPE_AGENT); }
DI unsigned xb_xcc_id() { return (unsigned)__builtin_amdgcn_s_getreg((3 << 11) | 20) & 0xFu; }
#define XB_SPIN(cond, bar)                                                         \
  do {                                                                             \
    unsigned _sp = 0;                                                              \
    while (cond) {                                                                 \
      __builtin_amdgcn_s_sleep(1);                                                 \
      if ((++_sp & 255u) == 0u) {                                                  \
        if (xb_ld(&(bar)[XB_TMO])) break;                                          \
        if (_sp > XB_SPIN_CAP) { atomicAdd(&(bar)[XB_TMO], 1u); break; }           \
      }                                                                            \
    }                                                                              \
  } while (0)
DI void xcd_barrier_complete(unsigned* bar, unsigned x, unsigned& nloc, unsigned& nx) {
  const unsigned G = gridDim.x;
  unsigned sum, cnt, mine, sp = 0u;
  for (;;) {
    sum = 0u; cnt = 0u; mine = 0u;
#pragma unroll
    for (unsigned j = 0; j < 16; ++j) {
      const unsigned c = xb_ld(&bar[XB_XCNT(j)]);
      sum += c;
      cnt += (c > 0u) ? 1u : 0u;
      mine = (j == x) ? c : mine;
    }
    if (sum == G) break;
    __builtin_amdgcn_s_sleep(1);
    if ((++sp & 255u) == 0u) {
      if (xb_ld(&bar[XB_TMO])) break;
      if (sp > XB_SPIN_CAP) { atomicAdd(&bar[XB_TMO], 1u); break; }
    }
  }
  nloc = mine > 0u ? mine : 1u;
  nx = cnt > 0u ? cnt : 1u;
}
DI void xcd_barrier(unsigned* bar, volatile LAS unsigned* st) {
  asm volatile("s_waitcnt vmcnt(0)" ::: "memory");
  __syncthreads();
  if (threadIdx.x == 0) {
    const unsigned x = xb_xcc_id();
    __builtin_amdgcn_s_waitcnt(0);
    unsigned nloc = st[0], nx = st[1];
    if (nloc == 0u) {
      xcd_barrier_complete(bar, x, nloc, nx);
      st[0] = nloc;
      st[1] = nx;
    }
    const unsigned old = xb_add(&bar[XB_XSUB(x)], 1u);
    const unsigned gen = old / nloc;
    if (old + 1u == (gen + 1u) * nloc) {
      __builtin_amdgcn_fence(__ATOMIC_RELEASE, "agent");
      asm volatile("s_waitcnt vmcnt(0)" ::: "memory");
      const unsigned og = xb_add(&bar[XB_TOP], 1u);
      const unsigned tg = og / nx;
      if (og + 1u == (tg + 1u) * nx) xb_add(&bar[XB_TOPGEN], 1u);
      else XB_SPIN(xb_ld(&bar[XB_TOPGEN]) == tg, bar);
      __builtin_amdgcn_fence(__ATOMIC_ACQUIRE, "agent");
      xb_add(&bar[XB_XGEN(x)], 1u);
      asm volatile("s_waitcnt vmcnt(0)" ::: "memory");
    } else {
      XB_SPIN(xb_ld(&bar[XB_XGEN(x)]) == gen, bar);
      __builtin_amdgcn_fence(__ATOMIC_ACQUIRE, "agent");
      asm volatile("s_waitcnt vmcnt(0)" ::: "memory");
    }
  }
  __syncthreads();
}

constexpr int SMEM_BYTES = 57344;
constexpr int N_PHASES = 22;
constexpr int PREP_N = CV_TOTAL + 272 + 512;

template <class F>
DI void xcd_tiles(unsigned* q, int n_tm, int n_tn, char* smem, F&& f) {
  volatile LAS unsigned* qslot = (volatile LAS unsigned*)(smem + SMEM_BYTES - 8);
  const int tmp = n_tm >> 3, R = tmp * n_tn;
  const int x0 = (int)(xb_xcc_id() & 7u);
  const bool leader = tidx() == 0;
  int dx = 0, raw = 0;
  if (leader) raw = (int)xb_add(q + x0 * 16, 1u);
  for (;;) {
    __syncthreads();
    if (leader) {
      while (raw >= R && dx < 8) {
        ++dx;
        if (dx < 8) raw = (int)xb_add(q + ((x0 + dx) & 7) * 16, 1u);
      }
      *qslot = dx < 8 ? (unsigned)(((x0 + dx) & 7) * R + raw) : 0xffffffffu;
    }
    __syncthreads();
    const int code = __builtin_amdgcn_readfirstlane((int)*qslot);
    if (code < 0) break;
    const int x = code / R, i = code - x * R;
    const int tn = i / tmp, tm = x * tmp + (i - tn * tmp);
    f(tm, tn, [&]() { if (leader) raw = (int)xb_add(q + x * 16, 1u); });
  }
}

DI void prep_item(const Params& p, int l, int item, char* smem) {
  if (item < 512) return s5prep_item(p, l, item, smem);
  item -= 512;
  if (item < 272) return hyf_item(p, l, item, smem);
  item -= 272;
  convert_item(p, l, item, smem);
}

DI void run_phase(const Params& pin, int ph, char* smem) {
  Params p = pin;
  asm volatile("" : "+s"(p.ws), "+s"(p.out));
  const int l = ph < 2 ? 0 : (ph - 2) / 10;
  const int sub = ph < 2 ? ph : 2 + (ph - 2) % 10;
  int nb = gridDim.x, b0 = blockIdx.x;
  asm volatile("" : "+s"(nb), "+s"(b0));
  const float* mod = (const float*)(p.ws + O_MOD);
  unsigned* gq = (unsigned*)(p.ws + O_BAR) + 4096 + ph * 256;
  const u16* hmix = (const u16*)(p.ws + O_HMIX);
  const float* xinP = l == 0 ? lnd(p.x_prompt) : p.out;
  const float* xinS = l == 0 ? lnd(p.x_sample) : p.out + (size_t)TP * 1024;
  switch (sub) {
    case 0: {
      const int n = 192 + 256 + 1 + PREP_N;
      for (int it = b0; it < n; it += nb) {
        if (it < 192) mod_item(p, it, smem);
        else if (it < 448) rope_item(p, it - 192);
        else if (it < 449) lbv_item(p);
        else prep_item(p, 0, it - 449, smem);
      }
    } break;
    case 1: {
      for (int it = b0; it < TT / 8; it += nb) ln_item(p, it, lnd(p.x_prompt), lnd(p.x_sample), nullptr, nullptr, mod, 0, 1);
    } break;
    case 2: {
      EpiWin epi{p, l};
      xcd_tiles(gq, 160, 12, smem, [&](int tm, int tn, auto hook) {
        gemm_tile_w(hmix, 1024, TT, (const u16*)(p.ws + O_WT_IN), 1024, 3072, 1024, tm, tn, epi, smem, hook);
      });
      for (int it = b0; it < 512; it += nb) s5expand_item(p, l, it);
    } break;
    case 3: {
      unsigned* qctr = (unsigned*)(p.ws + O_BAR) + 3584 + l * 64;
      volatile LAS unsigned* qslot = (volatile LAS unsigned*)(smem + SMEM_BYTES - 8);
      constexpr int N0 = 768, N1 = N0 + 512, N2 = N1 + 128, N3 = N2 + 128, N4 = N3 + 256, N5 = N4 + 160;
      for (;;) {
        __syncthreads();
        if (tidx() == 0) *qslot = xb_add(qctr, 1u);
        __syncthreads();
        const int it = __builtin_amdgcn_readfirstlane((int)*qslot);
        if (it >= N5) break;
        int type, idx;
        if (it < N0) {
          type = it < 256 ? 1 : 0;
          idx = it < 256 ? it : it - 256;
        } else if (it < N1) { type = 2; idx = it - N0; }
        else if (it < N2) { type = 3; idx = it - N1; }
        else if (it < N3) { type = 0; idx = 512 + it - N2; }
        else if (it < N4) { type = 4; idx = it - N3; }
        else { type = 5; idx = it - N4; }
        type = __builtin_amdgcn_readfirstlane(type);
        idx = __builtin_amdgcn_readfirstlane(idx);
        switch (type) {
          case 0:
#pragma unroll 1
            for (int r_ = 0; r_ < PQ_ATT; ++r_) { __syncthreads(); attn_item(p, l, idx, smem); }
            break;
          case 1:
#pragma unroll 1
            for (int r_ = 0; r_ < PQ_HY; ++r_) hyena_item<true>(p, l, idx, smem);
            break;
          case 2:
#pragma unroll 1
            for (int r_ = 0; r_ < PQ_H1; ++r_) hgrn_item<1>(p, l, idx, smem);
            break;
          case 3: hgrn_item<0>(p, l, idx, smem); break;
          case 4: hyena_item<false>(p, l, idx, smem); break;
          default: {
            const int g = idx / 10, r = idx % 10;
            EpiS5E epi{p, g};
            gemm_tile((const u16*)(p.ws + O_BCAT) + (size_t)g * NCH32 * 768, 768, NCH32,
                      (const u16*)(p.ws + O_EMAT) + (size_t)g * 256 * 512, 512, 256, 512, r >> 1, r & 1, epi, smem);
          }
        }
      }
    } break;
    case 4: {
      const int n = 160 + 512;
      for (int it = b0; it < n; it += nb) {
        if (it < 160) s5scan_item(p, l, it);
        else hgrn_scan_item(p, l, it - 160);
      }
    } break;
    case 5: {
      for (int it = b0; it < 512; it += nb) hgrn_item<2>(p, l, it, smem);
      for (int it = b0; it < 16 * 20; it += nb) {
        const int g = it / 20, r = it % 20;
        EpiS5Y epi{p, g};
        gemm_tile((const u16*)(p.ws + O_ACAT) + (size_t)g * 512 * 768, 768, 512,
                  (const u16*)(p.ws + O_BCAT) + (size_t)g * NCH32 * 768, 768, NCH32, 768, r / 5, r % 5, epi, smem);
      }
    } break;
    case 6: {
      EpiGlu epi{p, l};
      for (int it = b0; it < 160 * 2; it += nb)
        gemm_tile((const u16*)(p.ws + O_ZS5), 256, TT, (const u16*)(p.ws + O_WT_GLU), 256, 256, 256, it >> 1, it & 1, epi, smem);
      for (int it = b0; it < TT / 4; it += nb) hgrn_fin_item(p, l, it);
    } break;
    case 7: {
      EpiRes epi{p, xinP, xinS, mod + (size_t)l * 5 * 6144 + 2 * 1024};
      xcd_tiles(gq, 160, 8, smem, [&](int tm, int tn, auto hook) {
        gemm_tile(hmix, 1024, TT, (const u16*)(p.ws + O_WT_OUT), 1024, 1024, 1024, tm, tn, epi, smem, hook);
      });
    } break;
    case 8: {
      for (int it = b0; it < TT / 8; it += nb)
        ln_item(p, it, p.out, p.out + (size_t)TP * 1024, lnd(p.ln_g) + (l * 2 + 0) * 1024, lnd(p.ln_b) + (l * 2 + 0) * 1024,
                mod + (size_t)l * 5 * 6144, 3, 4);
    } break;
    case 9: {
      EpiFfnIn epi{p};
      xcd_tiles(gq, 160, 22, smem, [&](int tm, int tn, auto hook) {
        gemm_tile_w(hmix, 1024, TT, (const u16*)(p.ws + O_WT_FFI), 1024, 5632, 1024, tm, tn, epi, smem, hook);
      });
    } break;
    case 10: {
      EpiRes epi{p, p.out, p.out + (size_t)TP * 1024, mod + (size_t)l * 5 * 6144 + 5 * 1024};
      xcd_tiles(gq, 160, 8, smem, [&](int tm, int tn, auto hook) {
        gemm_tile((const u16*)(p.ws + O_ACT), 2816, TT, (const u16*)(p.ws + O_WT_FFO), 2816, 1024, 2816, tm, tn, epi, smem, hook);
      });
    } break;
    case 11: {
      const int n = TT / 8 + (l == 0 ? PREP_N : 0);
      for (int it = b0; it < n; it += nb) {
        if (it < TT / 8)
          ln_item(p, it, p.out, p.out + (size_t)TP * 1024, lnd(p.ln_g) + (l * 2 + 1) * 1024, lnd(p.ln_b) + (l * 2 + 1) * 1024,
                  l == 0 ? mod + (size_t)5 * 6144 : nullptr, 0, 1);
        else prep_item(p, 1, it - TT / 8, smem);
      }
    } break;
  }
}


#ifndef PROBE_CASE
#define PROBE_CASE 0
#endif
#ifndef EXTRA_BAR
#define EXTRA_BAR 0
#endif
#ifndef PROBE_REP
#define PROBE_REP 2
#endif
template <int PH>
DI void phase_seq(const Params& p, char* smem) {
  constexpr int sub_ = PH < 2 ? PH : 2 + (PH - 2) % 10;
  constexpr int reps_ = ((PROBE_CASE >> sub_) & 1) ? PROBE_REP : 1;
  run_phase(p, PH, smem);
  if constexpr (reps_ >= 2) run_phase(p, PH, smem);
  if constexpr (reps_ >= 3) run_phase(p, PH, smem);
  if constexpr (PH + 1 < N_PHASES) {
    unsigned* bar = (unsigned*)(p.ws + O_BAR);
    volatile LAS unsigned* st = (volatile LAS unsigned*)(smem + SMEM_BYTES - 16);
    if constexpr (PH == 0) {
      if (blockIdx.x == 0)
        for (int i = threadIdx.x; i < 16384; i += 256) bar[i] = 0u;
      if (threadIdx.x == 0) { st[0] = 0u; st[1] = 0u; }
      cg::this_grid().sync();
      if (threadIdx.x == 0) (void)xb_add(&bar[XB_XCNT(xb_xcc_id())], 1u);
    } else {
#pragma unroll
      for (int j_ = 0; j_ < 1 + EXTRA_BAR; ++j_) xcd_barrier(bar, st);
    }
    phase_seq<PH + 1>(p, smem);
  }
}

__global__ void __launch_bounds__(256, 2) k_mega(Params p) {
  __shared__ __attribute__((aligned(16))) char smem[SMEM_BYTES];
  phase_seq<0>(p, smem);
}

__global__ void __launch_bounds__(256, 2) k_phase(Params p, int ph) {
  __shared__ __attribute__((aligned(16))) char smem[SMEM_BYTES];
  run_phase(p, ph, smem);
}

extern "C" void kernel_launch(void* const* d_in, const int* in_sizes, int n_in, void* d_out, int out_size, void* d_ws,
                              size_t ws_size, hipStream_t stream) {
  Params p{};
  const float** pp = (const float**)&p;
  for (int i = 0; i < 37; ++i) pp[i] = (const float*)d_in[i];
  p.out = (float*)d_out;
  p.ws = (char*)d_ws;
  if (ws_size < WS_TOTAL) fprintf(stderr, "workspace too small: %zu < %zu\n", ws_size, (size_t)WS_TOTAL);
#if MULTI
  for (int ph = 0; ph < N_PHASES; ++ph) hipLaunchKernelGGL(k_phase, dim3(512), dim3(256), 0, stream, p, ph);
#else
  static int grid_blocks = 0;
  if (!grid_blocks) {
    int dev = 0, cus = 0, per_cu = 0;
    hipGetDevice(&dev);
    hipDeviceGetAttribute(&cus, hipDeviceAttributeMultiprocessorCount, dev);
    (void)hipOccupancyMaxActiveBlocksPerMultiprocessor(&per_cu, k_mega, 256, 0);
    if (per_cu > 2) per_cu = 2;
    grid_blocks = cus * per_cu;
  }
  void* args[] = {&p};
  hipError_t e = hipLaunchCooperativeKernel((void*)k_mega, dim3(grid_blocks), dim3(256), args, 0, stream);
  if (e != hipSuccess) fprintf(stderr, "cooperative launch failed: %s (grid %d)\n", hipGetErrorString(e), grid_blocks);
#endif
}
```
